# Optimizing an MI355X kernel written in HIP

```python
import math
import jax, jax.numpy as jnp
from jax import lax
import numpy as np

D_MODEL = 1024
BATCH = 4
SEQ = 8192
DEPTH = 2

N_EVEN = (DEPTH + 1) // 2
N_ODD = DEPTH // 2

CONV_A_CH = D_MODEL // 2
CONV_A_WIDTH = 31
LN_EPS = 1e-5

HEAD_DIM = 64
HEADS_PER_GROUP = 8
DILATED_GROUPS = ((128, 1), (512, 4), (2048, 16))
N_GROUPS = len(DILATED_GROUPS)
N_ATTN_HEADS = N_GROUPS * HEADS_PER_GROUP
ATTN_OUT = HEADS_PER_GROUP * HEAD_DIM
ATTN_IN = 3 * N_ATTN_HEADS * HEAD_DIM
AB_IN = 2 * CONV_A_CH + ATTN_IN
AB_CAT = CONV_A_CH + ATTN_OUT

NUM_BUCKETS = 32
REL_MAX_DISTANCE = 2048

SC_WIDTH = D_MODEL
SC_CONV_WIDTH = 3

D_FF = 4 * D_MODEL
RMS_EPS = 1e-6
NEG_INF = -1e30

kernel_name = 'hybrid_conformer_dilated_shortconv'


def rms_norm(x, g, eps=RMS_EPS):
    xf = x.astype(jnp.float32)
    y = xf * lax.rsqrt(jnp.mean(xf * xf, axis=-1, keepdims=True) + eps)
    return (y * g.astype(jnp.float32)).astype(x.dtype)


def layer_norm(x, g, b, eps=LN_EPS):
    xf = x.astype(jnp.float32)
    mu = jnp.mean(xf, axis=-1, keepdims=True)
    var = jnp.mean(jnp.square(xf - mu), axis=-1, keepdims=True)
    y = (xf - mu) * lax.rsqrt(var + eps) * g.astype(jnp.float32) + b.astype(jnp.float32)
    return y.astype(x.dtype)


def causal_depthwise_conv(x, w):
    k_width, ch = w.shape
    xp = jnp.pad(x, ((0, 0), (k_width - 1, 0), (0, 0)))
    return lax.conv_general_dilated(
        xp, w[:, None, :].astype(x.dtype), window_strides=(1,), padding='VALID',
        dimension_numbers=('NWC', 'WIO', 'NWC'), feature_group_count=ch)


def t5_causal_bucket(n):
    max_exact = NUM_BUCKETS // 2
    nf = jnp.maximum(n, 1).astype(jnp.float32)
    large = max_exact + (jnp.log(nf / max_exact) / math.log(REL_MAX_DISTANCE / max_exact)
                         * (NUM_BUCKETS - max_exact)).astype(jnp.int32)
    return jnp.where(n < max_exact, n, jnp.minimum(large, NUM_BUCKETS - 1))


def dilated_group_attention(q, k, v, bias_table, window, dilation):
    bsz, seq, heads, dh = q.shape
    steps = window // dilation
    span = steps * dilation
    seq_pad = -(-seq // span) * span
    n_blk = seq_pad // span

    def to_blocks(t):
        t = jnp.pad(t, ((0, 0), (0, seq_pad - seq), (0, 0), (0, 0)))
        t = t.reshape(bsz, n_blk, steps, dilation, heads, dh)
        return t.transpose(0, 3, 4, 1, 2, 5)

    def with_prev(t):
        prev = jnp.pad(t[:, :, :, :-1], ((0, 0), (0, 0), (0, 0), (1, 0), (0, 0), (0, 0)))
        return jnp.concatenate([prev, t], axis=4)

    qb = to_blocks(q)
    kc = with_prev(to_blocks(k))
    vc = with_prev(to_blocks(v))
    scores = jnp.einsum('bdhnqe,bdhnke->bdhnqk', qb, kc,
                        preferred_element_type=jnp.float32) * (dh ** -0.5)

    a_idx = jnp.arange(steps)[:, None]
    c_idx = jnp.arange(2 * steps)[None, :]
    m = a_idx + steps - c_idx
    band = (m >= 0) & (m <= steps)
    first = (jnp.arange(n_blk) == 0)[:, None, None] & (c_idx < steps)[None]
    valid = band[None] & ~first
    bucket = t5_causal_bucket(jnp.clip(m, 0, steps) * dilation)
    bias = bias_table[bucket].astype(jnp.float32).transpose(2, 0, 1)

    logits = jnp.where(valid, scores + bias[:, None], NEG_INF)
    mx = jnp.max(logits, axis=-1, keepdims=True)
    p = jnp.exp(logits - mx)
    den = jnp.sum(p, axis=-1)
    out = jnp.einsum('bdhnqk,bdhnke->bdhnqe', p, vc.astype(jnp.float32)) / den[..., None]
    lse = mx[..., 0] + jnp.log(den)
    out = out.transpose(0, 3, 4, 1, 2, 5).reshape(bsz, seq_pad, heads, dh)[:, :seq]
    lse = lse.transpose(0, 3, 4, 1, 2).reshape(bsz, seq_pad, heads)[:, :seq]
    return out, lse


def dilated_mixture_attention(qkv, rel_bias):
    bsz, seq, _ = qkv.shape
    qkv = qkv.reshape(bsz, seq, 3, N_GROUPS, HEADS_PER_GROUP, HEAD_DIM)
    outs, lses = [], []
    for g, (window, dilation) in enumerate(DILATED_GROUPS):
        o, l = dilated_group_attention(
            qkv[:, :, 0, g], qkv[:, :, 1, g], qkv[:, :, 2, g],
            rel_bias[:, g * HEADS_PER_GROUP:(g + 1) * HEADS_PER_GROUP], window, dilation)
        outs.append(o)
        lses.append(l)
    wts = jax.nn.softmax(jnp.stack(lses, axis=0), axis=0)
    out = jnp.sum(wts[..., None] * jnp.stack(outs, axis=0), axis=0)
    return out.reshape(bsz, seq, ATTN_OUT)


def conformer_conv_module(u, conv_w, conv_b, ln_g, ln_b):
    val, gate = jnp.split(u, 2, axis=-1)
    h = val * jax.nn.sigmoid(gate)
    h = causal_depthwise_conv(h, conv_w) + conv_b.astype(h.dtype)
    h = layer_norm(h, ln_g, ln_b)
    return jax.nn.silu(h)


def short_gated_conv(u, conv_w):
    b_gate, c_gate, val = jnp.split(u, 3, axis=-1)
    return b_gate * causal_depthwise_conv(c_gate * val, conv_w)


def setup_inputs(seed: int = 0) -> dict:
    key = jax.random.key(seed)
    ks = jax.random.split(key, 17)
    D = D_MODEL

    def nrm(k, shape, scale):
        return scale * jax.random.normal(k, shape, jnp.float32)

    return {
        'x': nrm(ks[0], (BATCH, SEQ, D), 1.0),
        'rel_bias': nrm(ks[1], (NUM_BUCKETS, N_ATTN_HEADS), 0.5),
        'ab_norm': 1.0 + nrm(ks[2], (N_EVEN, D), 0.01),
        'ab_w_in': nrm(ks[3], (N_EVEN, D, AB_IN), D ** -0.5),
        'ab_conv_w': nrm(ks[4], (N_EVEN, CONV_A_WIDTH, CONV_A_CH), CONV_A_WIDTH ** -0.5),
        'ab_conv_b': nrm(ks[5], (N_EVEN, CONV_A_CH), 0.01),
        'ab_ln_g': 1.0 + nrm(ks[6], (N_EVEN, CONV_A_CH), 0.01),
        'ab_ln_b': nrm(ks[7], (N_EVEN, CONV_A_CH), 0.01),
        'ab_w_out': nrm(ks[8], (N_EVEN, AB_CAT, D), AB_CAT ** -0.5),
        'sc_norm': 1.0 + nrm(ks[9], (N_ODD, D), 0.01),
        'sc_w_in': nrm(ks[10], (N_ODD, D, 3 * SC_WIDTH), D ** -0.5),
        'sc_conv_w': nrm(ks[11], (N_ODD, SC_CONV_WIDTH, SC_WIDTH), SC_CONV_WIDTH ** -0.5),
        'sc_w_out': nrm(ks[12], (N_ODD, SC_WIDTH, D), SC_WIDTH ** -0.5),
        'mlp_norm': 1.0 + nrm(ks[13], (DEPTH, D), 0.01),
        'mlp_w_up': nrm(ks[14], (DEPTH, D, D_FF), D ** -0.5),
        'mlp_w_down': nrm(ks[15], (DEPTH, D_FF, D), D_FF ** -0.5),
        'final_norm': 1.0 + nrm(ks[16], (D,), 0.01),
    }


def reference(x, rel_bias, ab_norm, ab_w_in, ab_conv_w, ab_conv_b, ab_ln_g, ab_ln_b,
              ab_w_out, sc_norm, sc_w_in, sc_conv_w, sc_w_out, mlp_norm, mlp_w_up,
              mlp_w_down, final_norm):
    h = x
    for layer in range(DEPTH):
        i = layer // 2
        if layer % 2 == 0:
            u = jnp.einsum('bsd,de->bse', rms_norm(h, ab_norm[i]), ab_w_in[i])
            ya = conformer_conv_module(u[..., :2 * CONV_A_CH], ab_conv_w[i], ab_conv_b[i],
                                       ab_ln_g[i], ab_ln_b[i])
            yb = dilated_mixture_attention(u[..., 2 * CONV_A_CH:], rel_bias).astype(ya.dtype)
            y = jnp.einsum('bsc,cd->bsd', jnp.concatenate([ya, yb], axis=-1), ab_w_out[i])
        else:
            u = jnp.einsum('bsd,de->bse', rms_norm(h, sc_norm[i]), sc_w_in[i])
            y = jnp.einsum('bsc,cd->bsd', short_gated_conv(u, sc_conv_w[i]), sc_w_out[i])
        h = h + y.astype(h.dtype)
        z = jnp.einsum('bsd,df->bsf', rms_norm(h, mlp_norm[layer]), mlp_w_up[layer])
        z = jnp.square(jax.nn.relu(z))
        h = h + jnp.einsum('bsf,fd->bsd', z, mlp_w_down[layer]).astype(h.dtype)
    return rms_norm(h, final_norm)
```

```cpp
#include <hip/hip_runtime.h>
#include <cstdio>
#include <cstdint>
#define MK_N_LAUNCHES 13
namespace pg8 {
#define PG8_LAS __attribute__((address_space(3)))
typedef unsigned short bf16_t;
typedef short bf16x8 __attribute__((ext_vector_type(8)));
typedef float f32x4 __attribute__((ext_vector_type(4)));
typedef unsigned u32x4 __attribute__((ext_vector_type(4)));
constexpr int BM = 256, BK = 64, HALF = 128, HTB = HALF * BK * 2  , STAGE_BYTES = 8 * HTB, NXCD = 8, WGM = 8;

__host__ __device__ __forceinline__ int lds_byte(int r, int c) { const int st = (r >> 4) * 2 + (c >> 5), rr = r & 15, cc = c & 31, ob = rr * 64 + cc * 2; return st * 1024 + (ob ^ (((ob >> 9) & 1) << 5)); }
__host__ __device__ __forceinline__ void stage_rc(int b, int& R, int& C) { const int st = b / 1024, sb = b % 1024, swz = sb ^ (((sb >> 9) & 1) << 5); R = (st >> 1) * 16 + swz / 64; C = (st & 1) * 32 + (swz % 64) / 2; }
__host__ __device__ __forceinline__ int perm32(int rho) { const int n = rho >> 4, i = rho & 15; return 8 * (i >> 2) + 4 * n + (i & 3); }

struct Unit { int pm, pn; };
struct Gemm { const bf16_t* A; const bf16_t* Bt; int M, N, K; };

struct StaticOrder {
    int nM, nN, nwg, G, c;
    __host__ __device__ void init(int M, int N, int G_, int c_) { nM = M / BM; nN = N / BM; nwg = nM * nN; G = G_; c = c_; }
    __host__ __device__ bool next(int i, Unit& u) const {
        const long L = (long)i * G + c; if (L >= nwg) return false;
        int wgid = (int)L; { const int q = nwg / NXCD, r = nwg % NXCD, xcd = wgid % NXCD, off = wgid / NXCD; wgid = (xcd < r ? xcd * (q + 1) : r * (q + 1) + (xcd - r) * q) + off; }
        const int nig = WGM * nN, gid = wgid / nig, fm = gid * WGM, gsz = (nM - fm) < WGM ? (nM - fm) : WGM;
        u.pm = fm + ((wgid % nig) % gsz); u.pn = (wgid % nig) / gsz; return true;
    }
    __device__ __forceinline__ void a_ready(const Unit&) const {}
    __device__ __forceinline__ void done(const Unit&) const {}
};
__device__ __forceinline__ unsigned cvt_pk_bf16(float lo, float hi) { unsigned r; asm volatile("v_cvt_pk_bf16_f32 %0, %1, %2" : "=v"(r) : "v"(lo), "v"(hi)); return r; }
typedef float f32x2 __attribute__((ext_vector_type(2)));
__device__ __forceinline__ void row_rstd(const float* stats, int row0, int fq, float (&rs)[2][4]) {
#pragma unroll
    for (int ai = 0; ai < 2; ++ai)
#pragma unroll
        for (int m = 0; m < 4; ++m) {
            const f32x4 v = *(const f32x4*)(stats + (size_t)(row0 + ai * HALF + m * 16) * 16 + 4 * fq);
            float s = (v[0] + v[1]) + (v[2] + v[3]);
            s += __shfl_xor(s, 16); s += __shfl_xor(s, 32);
            rs[ai][m] = __builtin_amdgcn_rsqf(s * (1.0f / 1024.0f) + 1e-6f);
        }
}
__device__ __forceinline__ u32x4 pack8(const f32x4 a, const f32x4 b) { u32x4 w; w.x = cvt_pk_bf16(a[0], a[1]); w.y = cvt_pk_bf16(a[2], a[3]); w.z = cvt_pk_bf16(b[0], b[1]); w.w = cvt_pk_bf16(b[2], b[3]); return w; }
__device__ __forceinline__ float sigmoidf_(float g) { return __builtin_amdgcn_rcpf(1.0f + __builtin_amdgcn_exp2f(-1.4426950408889634f * g)); }

struct EpiIn0 {
    static constexpr bool PERM = true, AFTER_DRAIN = false;
    bf16_t* hglu; bf16_t* qkv; const float* stats; float qscale;
    __device__ __forceinline__ void operator()(const f32x4 (&acc)[2][2][4][2], const Unit& u, int wr, int wc, int fr, int fq) const {
        const int row0 = u.pm * BM + wr * 64 + fr;
        float rs[2][4]; row_rstd(stats, row0, fq, rs);
        if (u.pn < 4) {
            const int col0 = u.pn * 128 + wc * 32 + 8 * fq;
#pragma unroll
            for (int ai = 0; ai < 2; ++ai)
#pragma unroll
                for (int m = 0; m < 4; ++m) {
                    const float r = rs[ai][m];
                    f32x4 v0 = acc[ai][0][m][0] * r, v1 = acc[ai][0][m][1] * r; const f32x4 g0 = acc[ai][1][m][0] * r, g1 = acc[ai][1][m][1] * r;
#pragma unroll
                    for (int j = 0; j < 4; ++j) { v0[j] *= sigmoidf_(g0[j]); v1[j] *= sigmoidf_(g1[j]); }
                    *(u32x4*)(hglu + (size_t)(row0 + ai * HALF + m * 16) * 512 + col0) = pack8(v0, v1);
                }
        } else {
            const int colt = (u.pn - 4) * BM; const float sc = colt < 1536 ? qscale : 1.0f; const int col0 = colt + wc * 32 + 8 * fq;
#pragma unroll
            for (int ai = 0; ai < 2; ++ai)
#pragma unroll
                for (int m = 0; m < 4; ++m) {
                    const float r = rs[ai][m] * sc; bf16_t* rowp = qkv + (size_t)(row0 + ai * HALF + m * 16) * 4608 + col0;
#pragma unroll
                    for (int bj = 0; bj < 2; ++bj) *(u32x4*)(rowp + bj * HALF) = pack8(acc[ai][bj][m][0] * r, acc[ai][bj][m][1] * r);
                }
        }
    }
};
struct EpiRes {
    static constexpr bool PERM = true, AFTER_DRAIN = false;
    const float* base; float* out; bf16_t* xb; float* stats;
    __device__ __forceinline__ void operator()(const f32x4 (&acc)[2][2][4][2], const Unit& u, int wr, int wc, int fr, int fq) const {
        const int row0 = u.pm * BM + wr * 64 + fr, col0 = u.pn * BM + wc * 32 + 8 * fq;
#pragma unroll
        for (int ai = 0; ai < 2; ++ai)
#pragma unroll
            for (int m = 0; m < 4; ++m) {
                const int row = row0 + ai * HALF + m * 16; const size_t off = (size_t)row * 1024 + col0; float ss = 0.f;
#pragma unroll
                for (int bj = 0; bj < 2; ++bj) {
                    const f32x4 b0 = *(const f32x4*)(base + off + bj * HALF), b1 = *(const f32x4*)(base + off + bj * HALF + 4);
                    const f32x4 o0 = b0 + acc[ai][bj][m][0], o1 = b1 + acc[ai][bj][m][1];
                    *(f32x4*)(out + off + bj * HALF) = o0; *(f32x4*)(out + off + bj * HALF + 4) = o1;
                    ss += (o0[0] * o0[0] + o0[1] * o0[1]) + (o0[2] * o0[2] + o0[3] * o0[3]) + (o1[0] * o1[0] + o1[1] * o1[1]) + (o1[2] * o1[2] + o1[3] * o1[3]);
                    if (xb) *(u32x4*)(xb + off + bj * HALF) = pack8(o0, o1);
                }
                ss += __shfl_xor(ss, 16); ss += __shfl_xor(ss, 32);
                if (fq == 0) stats[(size_t)row * 16 + u.pn * 4 + wc] = ss;
                if (m & 1) asm volatile("" ::: "memory");
            }
    }
};
struct EpiUp {
    static constexpr bool PERM = true, AFTER_DRAIN = false;
    bf16_t* z; const float* stats;
    __device__ __forceinline__ void operator()(const f32x4 (&acc)[2][2][4][2], const Unit& u, int wr, int wc, int fr, int fq) const {
        const int row0 = u.pm * BM + wr * 64 + fr, col0 = u.pn * BM + wc * 32 + 8 * fq;
        float rs[2][4]; row_rstd(stats, row0, fq, rs);
#pragma unroll
        for (int ai = 0; ai < 2; ++ai)
#pragma unroll
            for (int m = 0; m < 4; ++m) {
                const float r = rs[ai][m]; bf16_t* rowp = z + (size_t)(row0 + ai * HALF + m * 16) * 4096 + col0;
#pragma unroll
                for (int bj = 0; bj < 2; ++bj) {
                    f32x4 a = acc[ai][bj][m][0] * r, b = acc[ai][bj][m][1] * r;
#pragma unroll
                    for (int j = 0; j < 4; ++j) { const float x = fmaxf(a[j], 0.f), y = fmaxf(b[j], 0.f); a[j] = x * x; b[j] = y * y; }
                    *(u32x4*)(rowp + bj * HALF) = pack8(a, b);
                }
            }
    }
};
struct EpiIn1 {
    static constexpr bool PERM = true, AFTER_DRAIN = false;
    bf16_t* cv; bf16_t* bg; const float* stats;
    __device__ __forceinline__ void operator()(const f32x4 (&acc)[2][2][4][2], const Unit& u, int wr, int wc, int fr, int fq) const {
        const int row0 = u.pm * BM + wr * 64 + fr;
        float rs[2][4]; row_rstd(stats, row0, fq, rs);
        if (u.pn < 8) {
            const int col0 = u.pn * 128 + wc * 32 + 8 * fq;
#pragma unroll
            for (int ai = 0; ai < 2; ++ai)
#pragma unroll
                for (int m = 0; m < 4; ++m) {
                    const float r2 = rs[ai][m] * rs[ai][m];
                    *(u32x4*)(cv + (size_t)(row0 + ai * HALF + m * 16) * 1024 + col0) = pack8(acc[ai][0][m][0] * acc[ai][1][m][0] * r2, acc[ai][0][m][1] * acc[ai][1][m][1] * r2);
                }
        } else {
            const int col0 = (u.pn - 8) * BM + wc * 32 + 8 * fq;
#pragma unroll
            for (int ai = 0; ai < 2; ++ai)
#pragma unroll
                for (int m = 0; m < 4; ++m) {
                    const float r = rs[ai][m]; bf16_t* rowp = bg + (size_t)(row0 + ai * HALF + m * 16) * 1024 + col0;
#pragma unroll
                    for (int bj = 0; bj < 2; ++bj) *(u32x4*)(rowp + bj * HALF) = pack8(acc[ai][bj][m][0] * r, acc[ai][bj][m][1] * r);
                }
        }
    }
};
template <class Epi, class Sched, bool ALIGN_EPI = false, bool SP2 = false>
__device__ __forceinline__ void gemm_phase(PG8_LAS unsigned char* lds, const Gemm g, const Sched& S, const Epi& E) {
    const int tid = threadIdx.x, wid = __builtin_amdgcn_readfirstlane(tid >> 6), lane = tid & 63, wr = wid >> 2, wc = wid & 3, fr = lane & 15, fq = lane >> 4;
    const int K = g.K, nt = K / BK;
    unsigned voffA[2], voffB[2];
#pragma unroll
    for (int i = 0; i < 2; ++i) { int R, C; stage_rc(tid * 16 + i * 8192, R, C); const int Rb = Epi::PERM ? ((R & ~31) + perm32(R & 31)) : R;
        voffA[i] = (unsigned)(R * K + C) * 2u; voffB[i] = (unsigned)(Rb * K + C) * 2u; }
    const size_t kstep = (size_t)(BK * 2);
    const size_t hstep = (size_t)HALF * K * 2;
    const size_t tstep = 2 * hstep;
    const unsigned ldsw = (unsigned)wid * 1024u;
    const int aoff = lds_byte(wr * 64 + fr, fq * 8), boff = lds_byte(wc * 32 + fr, fq * 8);
#define PG8_SA(b, h) (((b) * 2 + (h)) * HTB)
#define PG8_SB(b, h) ((4 + (b) * 2 + (h)) * HTB)
#define PG8_STAGE(bufoff, gbase, voff) do { _Pragma("unroll") for (int _i = 0; _i < 2; ++_i) \
        __builtin_amdgcn_global_load_lds((const unsigned*)((const char*)(gbase) + (voff)[_i]), (PG8_LAS unsigned*)(lds + (bufoff) + ldsw + _i * 8192), 16, 0, 0); } while (0)
#define PG8_LDA(dst, b, h) do { _Pragma("unroll") for (int m = 0; m < 4; ++m) _Pragma("unroll") for (int k = 0; k < 2; ++k) dst[m][k] = *(const PG8_LAS bf16x8*)(lds + PG8_SA(b, h) + aoff + m * 2048 + k * 1024); } while (0)
#define PG8_LDB(dst, b, h) do { _Pragma("unroll") for (int n = 0; n < 2; ++n) _Pragma("unroll") for (int k = 0; k < 2; ++k) dst[n][k] = *(const PG8_LAS bf16x8*)(lds + PG8_SB(b, h) + boff + n * 2048 + k * 1024); } while (0)
#define PG8_MMA(ai, bj, At, Bt) do { __builtin_amdgcn_s_setprio(1); _Pragma("unroll") for (int m = 0; m < 4; ++m) _Pragma("unroll") for (int n = 0; n < 2; ++n) _Pragma("unroll") for (int k = 0; k < 2; ++k) \
        acc[ai][bj][m][n] = __builtin_amdgcn_mfma_f32_16x16x32_bf16(Bt[n][k], At[m][k], acc[ai][bj][m][n], 0, 0, 0); __builtin_amdgcn_s_setprio(0); } while (0)
#define PG8_WAIT_V(n) asm volatile("s_waitcnt vmcnt(" #n ")" ::: "memory")
#define PG8_WAIT_L(n) asm volatile("s_waitcnt lgkmcnt(" #n ")" ::: "memory")
#define PG8_BAR __builtin_amdgcn_s_barrier()
#define PG8_SCHED __builtin_amdgcn_sched_barrier(0)
    Unit cur, nxt; int ui = 0;
    if (!S.next(0, cur)) return;
    f32x4 acc[2][2][4][2];
#pragma unroll
    for (int a = 0; a < 2; ++a)
#pragma unroll
        for (int b = 0; b < 2; ++b)
#pragma unroll
            for (int m = 0; m < 4; ++m)
#pragma unroll
                for (int n = 0; n < 2; ++n) acc[a][b][m][n] = (f32x4){0.f, 0.f, 0.f, 0.f};
    bf16x8 At[4][2], B0[2][2], B1[2][2];
    const char* cA = (const char*)g.A + (size_t)cur.pm * tstep; const char* cB = (const char*)g.Bt + (size_t)cur.pn * tstep;
    S.a_ready(cur);
    if constexpr (SP2) {
        PG8_STAGE(PG8_SB(0, 0), cB, voffB); PG8_STAGE(PG8_SB(0, 1), cB + hstep, voffB); PG8_STAGE(PG8_SA(0, 0), cA, voffA); PG8_STAGE(PG8_SA(0, 1), cA + hstep, voffA);
        if (wr == 1) PG8_BAR;
        PG8_WAIT_V(2); PG8_BAR;
        PG8_STAGE(PG8_SB(1, 0), cB + kstep, voffB); PG8_STAGE(PG8_SA(1, 0), cA + kstep, voffA); PG8_STAGE(PG8_SB(1, 1), cB + hstep + kstep, voffB);
        PG8_WAIT_V(6); PG8_BAR;
    } else {
        PG8_STAGE(PG8_SB(0, 0), cB, voffB); PG8_STAGE(PG8_SA(0, 0), cA, voffA); PG8_STAGE(PG8_SB(0, 1), cB + hstep, voffB); PG8_STAGE(PG8_SA(0, 1), cA + hstep, voffA);
        if (wr == 1) PG8_BAR;
        PG8_WAIT_V(4); PG8_BAR;
        PG8_STAGE(PG8_SB(1, 0), cB + kstep, voffB); PG8_STAGE(PG8_SA(1, 0), cA + kstep, voffA); PG8_STAGE(PG8_SB(1, 1), cB + hstep + kstep, voffB);
        PG8_WAIT_V(6); PG8_BAR;
    }
    for (;;) {
        const bool has_next = S.next(ui + 1, nxt);
        const char* nA = has_next ? (const char*)g.A + (size_t)nxt.pm * tstep : cA; const char* nB = has_next ? (const char*)g.Bt + (size_t)nxt.pn * tstep : cB;
        for (int t = 0; t < nt; t += 2) {
            const bool last = (t == nt - 2);
            const char* a1 = cA + (size_t)(t + 1) * kstep;
            const char* a2 = last ? nA : cA + (size_t)(t + 2) * kstep; const char* b2 = last ? nB : cB + (size_t)(t + 2) * kstep;
            const char* a3 = a2 + kstep; const char* b3 = b2 + kstep;
            if (last && has_next) S.a_ready(nxt);
            if constexpr (SP2) {
            PG8_LDB(B0, 0, 0); PG8_LDB(B1, 0, 1); PG8_SCHED; PG8_LDA(At, 0, 0); PG8_STAGE(PG8_SA(1, 1), a1 + hstep, voffA);
            PG8_WAIT_V(8); PG8_WAIT_L(0); PG8_BAR; PG8_MMA(0, 0, At, B0); PG8_MMA(0, 1, At, B1); PG8_BAR; PG8_SCHED;
            PG8_LDA(At, 0, 1); PG8_STAGE(PG8_SB(0, 0), b2, voffB); PG8_STAGE(PG8_SB(0, 1), b2 + hstep, voffB); PG8_STAGE(PG8_SA(0, 0), a2, voffA);
            PG8_WAIT_V(8); PG8_WAIT_L(0); PG8_BAR; PG8_MMA(1, 0, At, B0); PG8_MMA(1, 1, At, B1); PG8_BAR; PG8_SCHED;
            PG8_LDB(B0, 1, 0); PG8_LDB(B1, 1, 1); PG8_SCHED; PG8_LDA(At, 1, 0); PG8_STAGE(PG8_SA(0, 1), a2 + hstep, voffA);
            PG8_WAIT_V(8); PG8_WAIT_L(0); PG8_BAR; PG8_MMA(0, 0, At, B0); PG8_MMA(0, 1, At, B1); PG8_BAR; PG8_SCHED;
            PG8_LDA(At, 1, 1); PG8_STAGE(PG8_SB(1, 0), b3, voffB); PG8_STAGE(PG8_SB(1, 1), b3 + hstep, voffB); PG8_STAGE(PG8_SA(1, 0), a3, voffA);
            PG8_WAIT_V(8); PG8_WAIT_L(0); PG8_BAR; PG8_MMA(1, 0, At, B0); PG8_MMA(1, 1, At, B1); PG8_BAR; PG8_SCHED;
            } else {
            PG8_LDB(B0, 0, 0); PG8_SCHED; PG8_LDA(At, 0, 0); PG8_STAGE(PG8_SA(1, 1), a1 + hstep, voffA);
            PG8_WAIT_L(8); PG8_BAR; PG8_WAIT_L(0); PG8_MMA(0, 0, At, B0); PG8_BAR; PG8_SCHED;
            PG8_LDB(B1, 0, 1); PG8_STAGE(PG8_SB(0, 0), b2, voffB);
            PG8_BAR; PG8_WAIT_L(0); PG8_MMA(0, 1, At, B1); PG8_BAR;
            PG8_LDA(At, 0, 1); PG8_STAGE(PG8_SA(0, 0), a2, voffA);
            PG8_BAR; PG8_WAIT_L(0); PG8_MMA(1, 0, At, B0); PG8_BAR; PG8_SCHED;
            PG8_STAGE(PG8_SB(0, 1), b2 + hstep, voffB);
            PG8_WAIT_V(6); PG8_BAR; PG8_MMA(1, 1, At, B1); PG8_BAR;
            PG8_LDB(B0, 1, 0); PG8_SCHED; PG8_LDA(At, 1, 0); PG8_STAGE(PG8_SA(0, 1), a2 + hstep, voffA);
            PG8_WAIT_L(8); PG8_BAR; PG8_WAIT_L(0); PG8_MMA(0, 0, At, B0); PG8_BAR; PG8_SCHED;
            PG8_LDB(B1, 1, 1); PG8_STAGE(PG8_SB(1, 0), b3, voffB);
            PG8_BAR; PG8_WAIT_L(0); PG8_MMA(0, 1, At, B1); PG8_BAR;
            PG8_LDA(At, 1, 1); PG8_STAGE(PG8_SA(1, 0), a3, voffA);
            PG8_BAR; PG8_WAIT_L(0); PG8_MMA(1, 0, At, B0); PG8_BAR; PG8_SCHED;
            PG8_STAGE(PG8_SB(1, 1), b3 + hstep, voffB);
            PG8_WAIT_V(6); PG8_BAR; PG8_MMA(1, 1, At, B1); PG8_BAR;
            }
        }
        if constexpr (ALIGN_EPI) { if (wr == 0) PG8_BAR; }
        if constexpr (!Epi::AFTER_DRAIN) { E(acc, cur, wr, wc, fr, fq); S.done(cur); }
        if (!has_next) break;
#pragma unroll
        for (int a = 0; a < 2; ++a)
#pragma unroll
            for (int b = 0; b < 2; ++b)
#pragma unroll
                for (int m = 0; m < 4; ++m)
#pragma unroll
                    for (int n = 0; n < 2; ++n) acc[a][b][m][n] = (f32x4){0.f, 0.f, 0.f, 0.f};
        cur = nxt; cA = nA; cB = nB; ++ui;
        if constexpr (ALIGN_EPI) { if (wr == 1) PG8_BAR; }
    }
    PG8_WAIT_V(0);
    if constexpr (!ALIGN_EPI) { if (wr == 0) PG8_BAR; }
    PG8_BAR;
    if constexpr (Epi::AFTER_DRAIN) { E.fused(acc, cur, wr, wc, fr, fq, lds, wid, lane); S.done(cur); }
#undef PG8_SA
#undef PG8_SB
#undef PG8_STAGE
#undef PG8_LDA
#undef PG8_LDB
#undef PG8_MMA
#undef PG8_WAIT_V
#undef PG8_WAIT_L
#undef PG8_BAR
#undef PG8_SCHED
}
}
#ifndef PG8_SP2
#define PG8_SP2 true
#endif
#ifndef PG8_ALIGN
#define PG8_ALIGN true
#endif
constexpr int CW_BAR = 4096;
#define GAS __attribute__((address_space(1)))
#define LAS __attribute__((address_space(3)))
typedef unsigned short bf16;
typedef unsigned v4u __attribute__((ext_vector_type(4)));
typedef float f32x4 __attribute__((ext_vector_type(4)));
typedef short bf16x8 __attribute__((ext_vector_type(8)));
typedef GAS unsigned gu32;
typedef GAS unsigned long long gu64;
#define RLX_AGENT __ATOMIC_RELAXED, __HIP_MEMORY_SCOPE_AGENT
#define LDS_WAIT() asm volatile("s_waitcnt lgkmcnt(0)" ::: "memory")
#define VM_WAIT() asm volatile("s_waitcnt vmcnt(0)" ::: "memory")
__device__ __forceinline__ unsigned long long rt() { return __builtin_amdgcn_s_memrealtime(); }
__device__ __forceinline__ unsigned f2bf(float f) { unsigned u = __builtin_bit_cast(unsigned, f); return (u + 0x7fffu + ((u >> 16) & 1u)) >> 16; }
__device__ __forceinline__ unsigned pk2(float lo, float hi) { return f2bf(lo) | (f2bf(hi) << 16); }

#define XB_TMO      128
#define XB_XCNT(j)  (256  + 64 * (j))
#define XB_XSUB(j)  (1280 + 64 * (j))
#define XB_XGEN(j)  (2304 + 64 * (j))
#define XB_TOP      3328
#define XB_TOPGEN   3392
#define XCD_BAR_WORDS 3456
#define XB_SPIN_CAP (1u << 18)

__device__ __forceinline__ unsigned xb_ld(unsigned* p)              { return __hip_atomic_load(p, __ATOMIC_RELAXED, __HIP_MEMORY_SCOPE_AGENT); }
__device__ __forceinline__ unsigned xb_add(unsigned* p, unsigned v) { return __hip_atomic_fetch_add(p, v, __ATOMIC_RELAXED, __HIP_MEMORY_SCOPE_AGENT); }
__device__ __forceinline__ unsigned xb_xcc_id() { return (unsigned)__builtin_amdgcn_s_getreg((3 << 11) | 20) & 0xFu; }
#define XB_SPIN(cond, bar) do { unsigned _sp = 0; while (cond) { __builtin_amdgcn_s_sleep(1); \
    if ((++_sp & 255u) == 0u) { if (xb_ld(&(bar)[XB_TMO])) break; if (_sp > XB_SPIN_CAP) { atomicAdd(&(bar)[XB_TMO], 1u); break; } } } } while (0)

struct XcdBarrier {
    unsigned* bar; unsigned x;
    volatile LAS unsigned* st;
};

__device__ __forceinline__ XcdBarrier xcd_barrier_post(unsigned* bar, volatile LAS unsigned* st) {
    XcdBarrier b; b.bar = bar; b.x = xb_xcc_id(); b.st = st;
    if (threadIdx.x == 0) (void)xb_add(&bar[XB_XCNT(b.x)], 1u);
    return b;
}
__device__ __forceinline__ void xcd_barrier_complete(unsigned* bar, unsigned x, unsigned& nloc, unsigned& nx) {
    const unsigned G = gridDim.x * gridDim.y * gridDim.z;
    unsigned sum, cnt, mine, sp = 0u;
    for (;;) {
        sum = 0u; cnt = 0u; mine = 0u;
#pragma unroll
        for (unsigned j = 0; j < 16; ++j) { const unsigned c = xb_ld(&bar[XB_XCNT(j)]); sum += c; cnt += (c > 0u) ? 1u : 0u; mine = (j == x) ? c : mine; }
        if (sum == G) break;
        __builtin_amdgcn_s_sleep(1);
        if ((++sp & 255u) == 0u) { if (xb_ld(&bar[XB_TMO])) break; if (sp > XB_SPIN_CAP) { atomicAdd(&bar[XB_TMO], 1u); break; } }
    }
    nloc = mine > 0u ? mine : 1u; nx = cnt > 0u ? cnt : 1u;
}

__device__ __forceinline__ void xcd_barrier(const XcdBarrier& b) {
    asm volatile("s_waitcnt vmcnt(0)" ::: "memory");
    __syncthreads();
    if (threadIdx.x == 0) {
        unsigned* bar = b.bar;
        __builtin_amdgcn_s_waitcnt(0);
        unsigned nloc = b.st[0], nx = b.st[1];
        if (nloc == 0u) { xcd_barrier_complete(bar, b.x, nloc, nx); b.st[0] = nloc; b.st[1] = nx; }
        const unsigned old = xb_add(&bar[XB_XSUB(b.x)], 1u);
        const unsigned gen = old / nloc;
        if (old + 1u == (gen + 1u) * nloc) {
            __builtin_amdgcn_fence(__ATOMIC_RELEASE, "agent");
            asm volatile("s_waitcnt vmcnt(0)" ::: "memory");
            const unsigned og = xb_add(&bar[XB_TOP], 1u);
            const unsigned tg = og / nx;
            if (og + 1u == (tg + 1u) * nx) xb_add(&bar[XB_TOPGEN], 1u);
            else XB_SPIN(xb_ld(&bar[XB_TOPGEN]) == tg, bar);
            __builtin_amdgcn_fence(__ATOMIC_ACQUIRE, "agent");
            xb_add(&bar[XB_XGEN(b.x)], 1u);
            asm volatile("s_waitcnt vmcnt(0)" ::: "memory");
        } else {
            XB_SPIN(xb_ld(&bar[XB_XGEN(b.x)]) == gen, bar);
            __builtin_amdgcn_fence(__ATOMIC_ACQUIRE, "agent");
            asm volatile("s_waitcnt vmcnt(0)" ::: "memory");
        }
    }
    __syncthreads();
}

constexpr int NWAVES = 8;
#ifndef MK_N_LAUNCHES
#define MK_N_LAUNCHES 1
#endif
constexpr int N_PHASES = 13;
constexpr int N_LAUNCHES = MK_N_LAUNCHES;

constexpr int BATCH = 4, SEQ = 8192, D = 1024, M = BATCH * SEQ, FF = 4096, N_IN0 = 5632, N_IN1 = 3072, NQKV = 4608, CA = 512, CONVW = 31;
constexpr float LOG2E = 1.4426950408889634f, QSCALE = 0.125f * LOG2E, RMS_EPS = 1e-6f, LN_EPS = 1e-5f;

constexpr size_t MiB = 1u << 20;
constexpr size_t WS_CTL = 0, CTL_ZERO_BYTES = 1 * MiB;
constexpr size_t WS_STATS = 1 * MiB;
constexpr size_t WS_BIAS2 = 3 * MiB;
constexpr size_t WS_LSE = 4 * MiB;
constexpr size_t WS_W_IN0 = 8 * MiB, WS_W_OUT0 = 19 * MiB, WS_W_UP0 = 21 * MiB, WS_W_DN0 = 29 * MiB, WS_W_IN1 = 37 * MiB, WS_W_OUT1 = 43 * MiB, WS_W_UP1 = 45 * MiB, WS_W_DN1 = 53 * MiB;
constexpr size_t WS_XB = 64 * MiB;
constexpr size_t WS_OG = 64 * MiB;
constexpr size_t WS_HGLU = 160 * MiB;
constexpr size_t WS_R2 = 192 * MiB;
constexpr size_t WS_END = 480 * MiB;

constexpr int RING_OFF = 0, RING_BYTES = 131072;
constexpr int LDSCTL_OFF = RING_BYTES, MISC_OFF = LDSCTL_OFF + 320;
constexpr int LDS_BYTES = 147456;

struct Frame {
    LAS unsigned char* lds;
    volatile LAS unsigned* MISC;
    gu32* ctl;
    int tid, lane, wave;
    int vcu, G;
};
struct Args { const float* in[17]; float* out; unsigned char* ws; int ph_lo, ph_hi, li, pad; };

__device__ __forceinline__ float wave_sum(float v) {
#pragma unroll
    for (int o = 1; o < 64; o <<= 1) v += __shfl_xor(v, o);
    return v;
}
__device__ __forceinline__ float bf2f(unsigned short b) { return __builtin_bit_cast(float, (unsigned)b << 16); }
__device__ __forceinline__ float bflo(unsigned w) { return __builtin_bit_cast(float, w << 16); }
__device__ __forceinline__ float bfhi(unsigned w) { return __builtin_bit_cast(float, w & 0xffff0000u); }

__device__ __forceinline__ int colmap(int mode, int n0) {
    if (mode == 1) { if (n0 < 512) return 256 * (n0 >> 7) + (n0 & 127); if (n0 < 1024) { const int c = n0 - 512; return 256 * (c >> 7) + 128 + (c & 127); } return n0; }
    if (mode == 2) { if (n0 < 1024) return 2048 + n0; if (n0 < 2048) { const int c = n0 - 1024; return 256 * (c >> 7) + (c & 127); } const int v = n0 - 2048; return 256 * (v >> 7) + 128 + (v & 127); }
    return n0;
}
__device__ __forceinline__ void p0_transpose_item(const float* W, int K, int N, bf16* WT, const float* gain, int mode, LAS float* scr, int item, int lane) {
    const int nblk = N / 32, kb = item / nblk, nb = item % nblk, k0 = 64 * kb, n0 = 32 * nb, r0 = colmap(mode, n0);
#pragma unroll 8
    for (int i = 0; i < 32; ++i) { const int kk = 2 * i + (lane >> 5); const float g = gain ? gain[k0 + kk] : 1.0f; scr[kk * 33 + (lane & 31)] = g * W[(size_t)(k0 + kk) * N + n0 + (lane & 31)]; }
    LDS_WAIT(); asm volatile("" ::: "memory");
    const int c = lane & 7;
#pragma unroll
    for (int j = 0; j < 4; ++j) { const int n = (lane >> 3) + 8 * j; const LAS float* s = scr + (8 * c) * 33 + n;
        v4u o; o.x = pk2(s[0 * 33], s[1 * 33]); o.y = pk2(s[2 * 33], s[3 * 33]); o.z = pk2(s[4 * 33], s[5 * 33]); o.w = pk2(s[6 * 33], s[7 * 33]);
        *(GAS v4u*)(WT + (size_t)(r0 + n) * K + k0 + 8 * c) = o; }
    LDS_WAIT(); asm volatile("" ::: "memory");
}
__device__ __forceinline__ void p0_prologue(Frame& F, const Args& a) {
    unsigned char* ws = a.ws;
    LAS float* scr = (LAS float*)(F.lds + RING_OFF + F.wave * 16384);
    const int gw = F.vcu * NWAVES + F.wave, NGW = F.G * NWAVES;
    constexpr int I_IN0 = (D / 64) * (N_IN0 / 32), I_SQ = (D / 64) * (D / 32), I_UP = (D / 64) * (FF / 32), I_DN = (FF / 64) * (D / 32), I_IN1 = (D / 64) * (N_IN1 / 32);
    constexpr int NITEMS = I_IN0 + 2 * I_SQ + 2 * I_UP + 2 * I_DN + I_IN1;
    for (int it = gw; it < NITEMS; it += NGW) {
        int r = it;
        if (r < I_IN0) { p0_transpose_item(a.in[3], D, N_IN0, (bf16*)(ws + WS_W_IN0), a.in[2], 1, scr, r, F.lane); continue; } r -= I_IN0;
        if (r < I_SQ) { p0_transpose_item(a.in[8], D, D, (bf16*)(ws + WS_W_OUT0), nullptr, 0, scr, r, F.lane); continue; } r -= I_SQ;
        if (r < I_UP) { p0_transpose_item(a.in[14], D, FF, (bf16*)(ws + WS_W_UP0), a.in[13], 0, scr, r, F.lane); continue; } r -= I_UP;
        if (r < I_DN) { p0_transpose_item(a.in[15], FF, D, (bf16*)(ws + WS_W_DN0), nullptr, 0, scr, r, F.lane); continue; } r -= I_DN;
        if (r < I_IN1) { p0_transpose_item(a.in[10], D, N_IN1, (bf16*)(ws + WS_W_IN1), a.in[9], 2, scr, r, F.lane); continue; } r -= I_IN1;
        if (r < I_SQ) { p0_transpose_item(a.in[12], D, D, (bf16*)(ws + WS_W_OUT1), nullptr, 0, scr, r, F.lane); continue; } r -= I_SQ;
        if (r < I_UP) { p0_transpose_item(a.in[14] + (size_t)D * FF, D, FF, (bf16*)(ws + WS_W_UP1), a.in[13] + D, 0, scr, r, F.lane); continue; } r -= I_UP;
        p0_transpose_item(a.in[15] + (size_t)FF * D, FF, D, (bf16*)(ws + WS_W_DN1), nullptr, 0, scr, r, F.lane);
    }
    const float* x = a.in[0]; bf16* xb = (bf16*)(ws + WS_XB); float* stats = (float*)(ws + WS_STATS);
    for (int m = gw; m < M; m += NGW) {
        const GAS f32x4* xr = (const GAS f32x4*)(x + (size_t)m * D) + F.lane;
        f32x4 v[4]; float s = 0.f;
#pragma unroll
        for (int j = 0; j < 4; ++j) { v[j] = xr[64 * j]; s += (v[j].x * v[j].x + v[j].y * v[j].y) + (v[j].z * v[j].z + v[j].w * v[j].w); }
        s = wave_sum(s);
        GAS unsigned long long* o8 = (GAS unsigned long long*)(xb + (size_t)m * D) + F.lane;
#pragma unroll
        for (int j = 0; j < 4; ++j) o8[64 * j] = (unsigned long long)pk2(v[j].x, v[j].y) | ((unsigned long long)pk2(v[j].z, v[j].w) << 32);
        if (F.lane < 16) stats[(size_t)m * 16 + F.lane] = F.lane == 0 ? s : 0.f;
    }
    if (blockIdx.x == 0) {
        float* b2 = (float*)(ws + WS_BIAS2); const float* rb = a.in[1];
        for (int i = F.tid; i < 24 * 129; i += NWAVES * 64) {
            const int gh = i / 129, m = i % 129, g = gh >> 3, n = m << (2 * g);
            int bucket = n;
            if (n >= 16) { const float nf = (float)n; const int large = 16 + (int)(logf(nf / 16.0f) / logf(128.0f) * 16.0f); bucket = large < 31 ? large : 31; }
            b2[gh * 132 + m] = LOG2E * rb[bucket * 24 + gh];
        }
    }
}

__device__ __forceinline__ void p2_attention_simple(Frame& F, const Args& a) {
    const bf16* qkv = (const bf16*)(a.ws + WS_R2); bf16* yb = (bf16*)(a.ws + WS_OG); const float* b2 = (const float*)(a.ws + WS_BIAS2);
    for (int idx = blockIdx.x * (NWAVES * 64) + F.tid; idx < M * 8; idx += F.G * NWAVES * 64) {
        const int row = idx >> 3, h = idx & 7, p = row & (SEQ - 1);
        float mrun = -1e30f, l = 0.f; float o[64];
#pragma unroll
        for (int i = 0; i < 64; ++i) o[i] = 0.f;
        for (int g = 0; g < 3; ++g) {
            const int d = 1 << (2 * g), gh = g * 8 + h;
            float q[64];
            { const v4u* qp = (const v4u*)(qkv + (size_t)row * NQKV + gh * 64);
#pragma unroll
              for (int c = 0; c < 8; ++c) { const v4u w = qp[c]; q[8 * c + 0] = bflo(w.x); q[8 * c + 1] = bfhi(w.x); q[8 * c + 2] = bflo(w.y); q[8 * c + 3] = bfhi(w.y); q[8 * c + 4] = bflo(w.z); q[8 * c + 5] = bfhi(w.z); q[8 * c + 6] = bflo(w.w); q[8 * c + 7] = bfhi(w.w); } }
            int nk = p / d; nk = (nk < 128 ? nk : 128) + 1;
            const float* bp = b2 + gh * 132;
            for (int m = 0; m < nk; ++m) {
                const bf16* kr = qkv + (size_t)(row - m * d) * NQKV + 1536 + gh * 64; const v4u* kp = (const v4u*)kr; const v4u* vp = (const v4u*)(kr + 1536);
                float s0 = 0.f, s1 = 0.f;
#pragma unroll
                for (int c = 0; c < 8; ++c) { const v4u w = kp[c];
                    s0 += q[8 * c + 0] * bflo(w.x); s1 += q[8 * c + 1] * bfhi(w.x); s0 += q[8 * c + 2] * bflo(w.y); s1 += q[8 * c + 3] * bfhi(w.y);
                    s0 += q[8 * c + 4] * bflo(w.z); s1 += q[8 * c + 5] * bfhi(w.z); s0 += q[8 * c + 6] * bflo(w.w); s1 += q[8 * c + 7] * bfhi(w.w); }
                const float s = s0 + s1 + bp[m];
                const float mn = fmaxf(mrun, s), al = __builtin_amdgcn_exp2f(mrun - mn), pc = __builtin_amdgcn_exp2f(s - mn);
                mrun = mn; l = l * al + pc;
#pragma unroll
                for (int c = 0; c < 8; ++c) { const v4u w = vp[c];
                    o[8 * c + 0] = o[8 * c + 0] * al + pc * bflo(w.x); o[8 * c + 1] = o[8 * c + 1] * al + pc * bfhi(w.x); o[8 * c + 2] = o[8 * c + 2] * al + pc * bflo(w.y); o[8 * c + 3] = o[8 * c + 3] * al + pc * bfhi(w.y);
                    o[8 * c + 4] = o[8 * c + 4] * al + pc * bflo(w.z); o[8 * c + 5] = o[8 * c + 5] * al + pc * bfhi(w.z); o[8 * c + 6] = o[8 * c + 6] * al + pc * bflo(w.w); o[8 * c + 7] = o[8 * c + 7] * al + pc * bfhi(w.w); }
            }
        }
        const float il = 1.0f / l; v4u* op = (v4u*)(yb + (size_t)row * 512 + h * 64);
#pragma unroll
        for (int c = 0; c < 8; ++c) { v4u w; w.x = pk2(o[8 * c + 0] * il, o[8 * c + 1] * il); w.y = pk2(o[8 * c + 2] * il, o[8 * c + 3] * il); w.z = pk2(o[8 * c + 4] * il, o[8 * c + 5] * il); w.w = pk2(o[8 * c + 6] * il, o[8 * c + 7] * il); op[c] = w; }
    }
}

__device__ __forceinline__ void p3_conv_cat_simple(Frame& F, const Args& a) {
    const bf16* hg = (const bf16*)(a.ws + WS_HGLU); const bf16* yb = (const bf16*)(a.ws + WS_OG); bf16* cat = (bf16*)(a.ws + WS_R2);
    const float* cw = a.in[4]; const float* cb = a.in[5]; const float* lg = a.in[6]; const float* lb = a.in[7];
    const int gw = F.vcu * NWAVES + F.wave, NGW = F.G * NWAVES, c0 = 8 * F.lane;
    for (int row = gw; row < M; row += NGW) {
        const int t = row & (SEQ - 1);
        float acc[8];
        { const f32x4 b0 = *(const f32x4*)(cb + c0), b1 = *(const f32x4*)(cb + c0 + 4); acc[0] = b0[0]; acc[1] = b0[1]; acc[2] = b0[2]; acc[3] = b0[3]; acc[4] = b1[0]; acc[5] = b1[1]; acc[6] = b1[2]; acc[7] = b1[3]; }
        const int kmin = t >= CONVW - 1 ? 0 : CONVW - 1 - t;
        for (int k = kmin; k < CONVW; ++k) {
            const v4u w = *(const v4u*)(hg + (size_t)(row - (CONVW - 1) + k) * CA + c0);
            const f32x4 w0 = *(const f32x4*)(cw + k * CA + c0), w1 = *(const f32x4*)(cw + k * CA + c0 + 4);
            acc[0] += w0[0] * bflo(w.x); acc[1] += w0[1] * bfhi(w.x); acc[2] += w0[2] * bflo(w.y); acc[3] += w0[3] * bfhi(w.y);
            acc[4] += w1[0] * bflo(w.z); acc[5] += w1[1] * bfhi(w.z); acc[6] += w1[2] * bflo(w.w); acc[7] += w1[3] * bfhi(w.w);
        }
        float s = 0.f;
#pragma unroll
        for (int j = 0; j < 8; ++j) s += acc[j];
        const float mu = wave_sum(s) * (1.0f / CA); float q = 0.f;
#pragma unroll
        for (int j = 0; j < 8; ++j) { acc[j] -= mu; q += acc[j] * acc[j]; }
        const float rstd = 1.0f / sqrtf(wave_sum(q) * (1.0f / CA) + LN_EPS);
        const f32x4 g0 = *(const f32x4*)(lg + c0), g1 = *(const f32x4*)(lg + c0 + 4), e0 = *(const f32x4*)(lb + c0), e1 = *(const f32x4*)(lb + c0 + 4);
        float y[8];
#pragma unroll
        for (int j = 0; j < 8; ++j) { const float gg = j < 4 ? g0[j] : g1[j - 4], bb = j < 4 ? e0[j] : e1[j - 4]; const float v = acc[j] * rstd * gg + bb; y[j] = v * __builtin_amdgcn_rcpf(1.0f + __builtin_amdgcn_exp2f(-LOG2E * v)); }
        v4u o; o.x = pk2(y[0], y[1]); o.y = pk2(y[2], y[3]); o.z = pk2(y[4], y[5]); o.w = pk2(y[6], y[7]);
        *(v4u*)(cat + (size_t)row * D + c0) = o;
        *(v4u*)(cat + (size_t)row * D + CA + c0) = *(const v4u*)(yb + (size_t)row * 512 + c0);
    }
}

__device__ __forceinline__ void p8_shortconv(Frame& F, const Args& a) {
    const bf16* bg = (const bf16*)(a.ws + WS_R2); const bf16* cv = (const bf16*)(a.ws + WS_R2 + 64 * MiB); bf16* y = (bf16*)(a.ws + WS_R2 + 128 * MiB);
    const float* w = a.in[11];
    for (int idx = blockIdx.x * (NWAVES * 64) + F.tid; idx < M * 128; idx += F.G * NWAVES * 64) {
        const int row = idx >> 7, c0 = 8 * (idx & 127), t = row & (SEQ - 1);
        float acc[8];
#pragma unroll
        for (int j = 0; j < 8; ++j) acc[j] = 0.f;
#pragma unroll
        for (int k = 0; k < 3; ++k) {
            if (t + k - 2 >= 0) {
                const v4u x = *(const v4u*)(cv + (size_t)(row + k - 2) * D + c0);
                const f32x4 w0 = *(const f32x4*)(w + k * D + c0), w1 = *(const f32x4*)(w + k * D + c0 + 4);
                acc[0] += w0[0] * bflo(x.x); acc[1] += w0[1] * bfhi(x.x); acc[2] += w0[2] * bflo(x.y); acc[3] += w0[3] * bfhi(x.y);
                acc[4] += w1[0] * bflo(x.z); acc[5] += w1[1] * bfhi(x.z); acc[6] += w1[2] * bflo(x.w); acc[7] += w1[3] * bfhi(x.w);
            }
        }
        const v4u b = *(const v4u*)(bg + (size_t)row * D + c0);
        v4u o; o.x = pk2(acc[0] * bflo(b.x), acc[1] * bfhi(b.x)); o.y = pk2(acc[2] * bflo(b.y), acc[3] * bfhi(b.y)); o.z = pk2(acc[4] * bflo(b.z), acc[5] * bfhi(b.z)); o.w = pk2(acc[6] * bflo(b.w), acc[7] * bfhi(b.w));
        *(v4u*)(y + (size_t)row * D + c0) = o;
    }
}

__device__ __forceinline__ void p12_final_norm(Frame& F, const Args& a) {
    const float* stats = (const float*)(a.ws + WS_STATS); const float* g = a.in[16]; float* out = a.out;
    const int gw = F.vcu * NWAVES + F.wave, NGW = F.G * NWAVES;
    f32x4 gv[4];
#pragma unroll
    for (int j = 0; j < 4; ++j) gv[j] = *(const f32x4*)(g + 4 * F.lane + 256 * j);
    for (int row = gw; row < M; row += NGW) {
        float s = stats[(size_t)row * 16 + (F.lane & 15)];
        s += __shfl_xor(s, 1); s += __shfl_xor(s, 2); s += __shfl_xor(s, 4); s += __shfl_xor(s, 8);
        const float rstd = 1.0f / sqrtf(s * (1.0f / D) + RMS_EPS);
        GAS f32x4* o = (GAS f32x4*)(out + (size_t)row * D) + F.lane;
#pragma unroll
        for (int j = 0; j < 4; ++j) { const f32x4 v = o[64 * j]; o[64 * j] = v * rstd * gv[j]; }
    }
}

__global__ void __launch_bounds__(NWAVES * 64, 2) hybrid_fwd(Args args) {
    extern __shared__ __attribute__((aligned(16))) unsigned char lds[];
    Frame F;
    F.lds = (LAS unsigned char*)lds;
    F.MISC = (volatile LAS unsigned*)(F.lds + MISC_OFF);
    F.tid = threadIdx.x; F.lane = F.tid & 63; F.wave = __builtin_amdgcn_readfirstlane(F.tid >> 6);
    F.G = gridDim.x; { const int bx = blockIdx.x; F.vcu = (F.G % 8 == 0) ? (bx % 8) * (F.G / 8) + bx / 8 : bx; }
    unsigned char* ws = args.ws;
    F.ctl = (gu32*)(ws + WS_CTL);
    for (int u = F.tid; u < (LDS_BYTES - LDSCTL_OFF) / 4; u += NWAVES * 64) ((LAS unsigned*)(F.lds + LDSCTL_OFF))[u] = 0u;
    __syncthreads();
    XcdBarrier bar; bar.bar = (unsigned*)(F.ctl + CW_BAR); bar.x = 0; bar.st = nullptr;
    if (N_LAUNCHES == 1) bar = xcd_barrier_post((unsigned*)(F.ctl + CW_BAR), F.MISC + 8);
#define GRID_BAR() do { if (N_LAUNCHES == 1) xcd_barrier(bar); } while (0)
    const int lo = args.ph_lo, hi = args.ph_hi;
#define IN(k) (lo <= (k) && (k) < hi)
#define BOTH(k) (IN(k) && IN((k) + 1))
    bf16* const xb = (bf16*)(ws + WS_XB); float* const stats = (float*)(ws + WS_STATS);
    bf16* const r2 = (bf16*)(ws + WS_R2);

    if (IN(0)) { p0_prologue(F, args); if (BOTH(0)) GRID_BAR(); }
    if (IN(1)) {
        pg8::Gemm g{xb, (const bf16*)(ws + WS_W_IN0), M, N_IN0, D}; pg8::StaticOrder S; S.init(M, N_IN0, F.G, (int)blockIdx.x);
        pg8::EpiIn0 E{(bf16*)(ws + WS_HGLU), r2, stats, QSCALE};
        pg8::gemm_phase<pg8::EpiIn0, pg8::StaticOrder, PG8_ALIGN, PG8_SP2>(F.lds + RING_OFF, g, S, E);
        if (BOTH(1)) GRID_BAR();
    }
    if (IN(2)) { p2_attention_simple(F, args); if (BOTH(2)) GRID_BAR(); }
    if (IN(3)) { p3_conv_cat_simple(F, args); if (BOTH(3)) GRID_BAR(); }
    if (IN(4)) {
        pg8::Gemm g{r2, (const bf16*)(ws + WS_W_OUT0), M, D, D}; pg8::StaticOrder S; S.init(M, D, F.G, (int)blockIdx.x);
        pg8::EpiRes E{args.in[0], args.out, xb, stats};
        pg8::gemm_phase<pg8::EpiRes, pg8::StaticOrder, PG8_ALIGN, PG8_SP2>(F.lds + RING_OFF, g, S, E);
        if (BOTH(4)) GRID_BAR();
    }
    if (IN(5)) {
        pg8::Gemm g{xb, (const bf16*)(ws + WS_W_UP0), M, FF, D}; pg8::StaticOrder S; S.init(M, FF, F.G, (int)blockIdx.x);
        pg8::EpiUp E{r2, stats};
        pg8::gemm_phase<pg8::EpiUp, pg8::StaticOrder, PG8_ALIGN, PG8_SP2>(F.lds + RING_OFF, g, S, E);
        if (BOTH(5)) GRID_BAR();
    }
    if (IN(6)) {
        pg8::Gemm g{r2, (const bf16*)(ws + WS_W_DN0), M, D, FF}; pg8::StaticOrder S; S.init(M, D, F.G, (int)blockIdx.x);
        pg8::EpiRes E{args.out, args.out, xb, stats};
        pg8::gemm_phase<pg8::EpiRes, pg8::StaticOrder, PG8_ALIGN, PG8_SP2>(F.lds + RING_OFF, g, S, E);
        if (BOTH(6)) GRID_BAR();
    }
    if (IN(7)) {
        pg8::Gemm g{xb, (const bf16*)(ws + WS_W_IN1), M, N_IN1, D}; pg8::StaticOrder S; S.init(M, N_IN1, F.G, (int)blockIdx.x);
        pg8::EpiIn1 E{(bf16*)(ws + WS_R2 + 64 * MiB), r2, stats};
        pg8::gemm_phase<pg8::EpiIn1, pg8::StaticOrder, PG8_ALIGN, PG8_SP2>(F.lds + RING_OFF, g, S, E);
        if (BOTH(7)) GRID_BAR();
    }
    if (IN(8)) { p8_shortconv(F, args); if (BOTH(8)) GRID_BAR(); }
    if (IN(9)) {
        pg8::Gemm g{(const bf16*)(ws + WS_R2 + 128 * MiB), (const bf16*)(ws + WS_W_OUT1), M, D, D}; pg8::StaticOrder S; S.init(M, D, F.G, (int)blockIdx.x);
        pg8::EpiRes E{args.out, args.out, xb, stats};
        pg8::gemm_phase<pg8::EpiRes, pg8::StaticOrder, PG8_ALIGN, PG8_SP2>(F.lds + RING_OFF, g, S, E);
        if (BOTH(9)) GRID_BAR();
    }
    if (IN(10)) {
        pg8::Gemm g{xb, (const bf16*)(ws + WS_W_UP1), M, FF, D}; pg8::StaticOrder S; S.init(M, FF, F.G, (int)blockIdx.x);
        pg8::EpiUp E{r2, stats};
        pg8::gemm_phase<pg8::EpiUp, pg8::StaticOrder, PG8_ALIGN, PG8_SP2>(F.lds + RING_OFF, g, S, E);
        if (BOTH(10)) GRID_BAR();
    }
    if (IN(11)) {
        pg8::Gemm g{r2, (const bf16*)(ws + WS_W_DN1), M, D, FF}; pg8::StaticOrder S; S.init(M, D, F.G, (int)blockIdx.x);
        pg8::EpiRes E{args.out, args.out, nullptr, stats};
        pg8::gemm_phase<pg8::EpiRes, pg8::StaticOrder, PG8_ALIGN, PG8_SP2>(F.lds + RING_OFF, g, S, E);
        if (BOTH(11)) GRID_BAR();
    }
    if (IN(12)) { p12_final_norm(F, args); }
#undef IN
#undef BOTH
}

extern "C" void kernel_launch(void* const* d_in, const int* in_sizes, int n_in, void* d_out, int out_size, void* d_ws, size_t ws_size, hipStream_t stream) {
    static int grid = 0;
    if (grid == 0) {
        if (n_in != 17 || in_sizes[0] != M * D || out_size != M * D || ws_size < WS_END) { fprintf(stderr, "kernel_launch: shape/workspace mismatch (n_in %d in0 %d out %d ws %zu, need %zu)\n", n_in, n_in > 0 ? in_sizes[0] : -1, out_size, ws_size, (size_t)WS_END); grid = -1; return; }
        int dev = 0, cus = 0, per_cu = 0;
        if (hipGetDevice(&dev) != hipSuccess || hipDeviceGetAttribute(&cus, hipDeviceAttributeMultiprocessorCount, dev) != hipSuccess) { grid = -1; return; }
        if (hipFuncSetAttribute((const void*)hybrid_fwd, hipFuncAttributeMaxDynamicSharedMemorySize, LDS_BYTES) != hipSuccess) { fprintf(stderr, "kernel_launch: hipFuncSetAttribute failed\n"); grid = -1; return; }
        if (hipOccupancyMaxActiveBlocksPerMultiprocessor(&per_cu, (const void*)hybrid_fwd, NWAVES * 64, LDS_BYTES) != hipSuccess || per_cu < 1) { fprintf(stderr, "kernel_launch: occupancy query says %d workgroups per CU\n", per_cu); }
        (void)hipGetLastError();
        grid = cus;
    }
    if (grid < 0) return;
    if (hipMemsetAsync((char*)d_ws + WS_CTL, 0, CTL_ZERO_BYTES, stream) != hipSuccess) return;
    Args a{};
    for (int i = 0; i < 17; ++i) a.in[i] = (const float*)d_in[i];
    a.out = (float*)d_out; a.ws = (unsigned char*)d_ws;
    for (int li = 0; li < N_LAUNCHES; ++li) {
        a.ph_lo = (N_LAUNCHES == 1) ? 0 : li; a.ph_hi = (N_LAUNCHES == 1) ? N_PHASES : li + 1; a.li = li;
        hipLaunchKernelGGL(hybrid_fwd, dim3(grid), dim3(NWAVES * 64), LDS_BYTES, stream, a);
    }
}
```

```cpp
#include <hip/hip_runtime.h>
#include <cstdio>
#include <cstdint>
namespace pg8 {
#define PG8_LAS __attribute__((address_space(3)))
typedef unsigned short bf16_t;
typedef short bf16x8 __attribute__((ext_vector_type(8)));
typedef float f32x4 __attribute__((ext_vector_type(4)));
typedef unsigned u32x4 __attribute__((ext_vector_type(4)));
constexpr int BM = 256, BK = 64, HALF = 128, HTB = HALF * BK * 2  , STAGE_BYTES = 8 * HTB, NXCD = 8, WGM = 8;

__host__ __device__ __forceinline__ int lds_byte(int r, int c) { const int st = (r >> 4) * 2 + (c >> 5), rr = r & 15, cc = c & 31, ob = rr * 64 + cc * 2; return st * 1024 + (ob ^ (((ob >> 9) & 1) << 5)); }
__host__ __device__ __forceinline__ void stage_rc(int b, int& R, int& C) { const int st = b / 1024, sb = b % 1024, swz = sb ^ (((sb >> 9) & 1) << 5); R = (st >> 1) * 16 + swz / 64; C = (st & 1) * 32 + (swz % 64) / 2; }
__host__ __device__ __forceinline__ int perm32(int rho) { const int n = rho >> 4, i = rho & 15; return 8 * (i >> 2) + 4 * n + (i & 3); }

struct Unit { int pm, pn, idx; };
struct Gemm { const bf16_t* A; const bf16_t* Bt; int M, N, K; };

struct StaticOrder {
    int nM, nN, nwg, G, c;
    __host__ __device__ void init(int M, int N, int G_, int c_) { nM = M / BM; nN = N / BM; nwg = nM * nN; G = G_; c = c_; }
    __host__ __device__ bool next(int i, Unit& u) const {
        const long L = (long)i * G + c; if (L >= nwg) return false;
        int wgid = (int)L; { const int q = nwg / NXCD, r = nwg % NXCD, xcd = wgid % NXCD, off = wgid / NXCD; wgid = (xcd < r ? xcd * (q + 1) : r * (q + 1) + (xcd - r) * q) + off; }
        const int nig = WGM * nN, gid = wgid / nig, fm = gid * WGM, gsz = (nM - fm) < WGM ? (nM - fm) : WGM;
        u.pm = fm + ((wgid % nig) % gsz); u.pn = (wgid % nig) / gsz; u.idx = i; return true;
    }
    __device__ __forceinline__ void a_ready(const Unit&) const {}
    __device__ __forceinline__ void done(const Unit&) const {}
};
__device__ __forceinline__ unsigned cvt_pk_bf16(float lo, float hi) { unsigned r; asm volatile("v_cvt_pk_bf16_f32 %0, %1, %2" : "=v"(r) : "v"(lo), "v"(hi)); return r; }
typedef float f32x2 __attribute__((ext_vector_type(2)));
#if defined(PROBE_KREP)
constexpr float KSC = 1.0f / PROBE_KREP;
#else
constexpr float KSC = 1.0f;
#endif
__device__ __forceinline__ void row_rstd(const PG8_LAS float* rstab, const Unit& u, int wr, int fr, float (&rs)[2][4]) {
#pragma unroll
    for (int ai = 0; ai < 2; ++ai)
#pragma unroll
        for (int m = 0; m < 4; ++m) rs[ai][m] = rstab[u.idx * BM + ai * HALF + wr * 64 + m * 16 + fr];
}
__device__ __forceinline__ u32x4 pack8(const f32x4 a, const f32x4 b) { u32x4 w; w.x = cvt_pk_bf16(a[0], a[1]); w.y = cvt_pk_bf16(a[2], a[3]); w.z = cvt_pk_bf16(b[0], b[1]); w.w = cvt_pk_bf16(b[2], b[3]); return w; }
#ifndef EPI_ST_SC1
#define EPI_ST_SC1 0
#endif
__device__ __forceinline__ void st16(bf16_t* p, const u32x4 v) {
#if EPI_ST_SC1
    asm volatile("global_store_dwordx4 %0, %1, off sc1\n\ts_nop 1" :: "v"(p), "v"(v) : "memory");
#else
    *(u32x4*)p = v;
#endif
}
__device__ __forceinline__ float sigmoidf_(float g) { return __builtin_amdgcn_rcpf(1.0f + __builtin_amdgcn_exp2f(-1.4426950408889634f * g)); }

struct EpiIn0 {
    static constexpr bool PERM = true, AFTER_DRAIN = false, IDEMP = false;
    bf16_t* hglu; bf16_t* qkv; const PG8_LAS float* rstab; float qscale;
    __device__ __forceinline__ void operator()(const f32x4 (&acc)[2][2][4][2], const Unit& u, int wr, int wc, int fr, int fq) const {
        const int row0 = u.pm * BM + wr * 64 + fr;
        float rs[2][4]; row_rstd(rstab, u, wr, fr, rs);
        if (u.pn < 4) {
            const int col0 = u.pn * 128 + wc * 32 + 8 * fq;
#pragma unroll
            for (int ai = 0; ai < 2; ++ai)
#pragma unroll
                for (int m = 0; m < 4; ++m) {
                    const float r = rs[ai][m];
                    f32x4 v0 = acc[ai][0][m][0] * r, v1 = acc[ai][0][m][1] * r; const f32x4 g0 = acc[ai][1][m][0] * r, g1 = acc[ai][1][m][1] * r;
#pragma unroll
                    for (int j = 0; j < 4; ++j) { v0[j] *= sigmoidf_(g0[j]); v1[j] *= sigmoidf_(g1[j]); }
                    st16(hglu + (size_t)(row0 + ai * HALF + m * 16) * 512 + col0, pack8(v0, v1));
                }
        } else {
            const int colt = (u.pn - 4) * BM; const float sc = colt < 1536 ? qscale : 1.0f; const int g2 = 2 * ((colt >> 9) % 3);
#pragma unroll
            for (int ai = 0; ai < 2; ++ai)
#pragma unroll
                for (int m = 0; m < 4; ++m) {
                    const float r = rs[ai][m] * sc; const int row = row0 + ai * HALF + m * 16, b = row >> 13, p = row & 8191;
                    const int pp = ((p & ((1 << g2) - 1)) << (13 - g2)) + (p >> g2);
#pragma unroll
                    for (int bj = 0; bj < 2; ++bj) { const int col = colt + bj * HALF + wc * 32 + 8 * fq;
                        st16(qkv + ((size_t)(((col >> 6) * 4 + b) * 8192 + pp) << 6) + (col & 63), pack8(acc[ai][bj][m][0] * r, acc[ai][bj][m][1] * r)); }
                }
        }
    }
};
__device__ __forceinline__ float bflo_(unsigned w) { return __builtin_bit_cast(float, w << 16); }
__device__ __forceinline__ float bfhi_(unsigned w) { return __builtin_bit_cast(float, w & 0xffff0000u); }
struct EpiRes {
    static constexpr bool PERM = true, AFTER_DRAIN = false, IDEMP = false;
    bf16_t* xb; float* stats;
    __device__ __forceinline__ void operator()(const f32x4 (&acc)[2][2][4][2], const Unit& u, int wr, int wc, int fr, int fq) const {
        const int row0 = u.pm * BM + wr * 64 + fr, col0 = u.pn * BM + wc * 32 + 8 * fq;
#pragma unroll
        for (int ai = 0; ai < 2; ++ai)
#pragma unroll
            for (int m = 0; m < 4; ++m) {
                const int row = row0 + ai * HALF + m * 16; const size_t off = (size_t)row * 1024 + col0; float ss = 0.f;
#pragma unroll
                for (int bj = 0; bj < 2; ++bj) {
                    const u32x4 b = *(const u32x4*)(xb + off + bj * HALF);
                    const f32x4 o0 = (f32x4){bflo_(b.x), bfhi_(b.x), bflo_(b.y), bfhi_(b.y)} + acc[ai][bj][m][0] * KSC, o1 = (f32x4){bflo_(b.z), bfhi_(b.z), bflo_(b.w), bfhi_(b.w)} + acc[ai][bj][m][1] * KSC;
                    ss += (o0[0] * o0[0] + o0[1] * o0[1]) + (o0[2] * o0[2] + o0[3] * o0[3]) + (o1[0] * o1[0] + o1[1] * o1[1]) + (o1[2] * o1[2] + o1[3] * o1[3]);
                    st16(xb + off + bj * HALF, pack8(o0, o1));
                }
                ss += __shfl_xor(ss, 16); ss += __shfl_xor(ss, 32);
                if (fq == 0) stats[(size_t)row * 16 + u.pn * 4 + wc] = ss;
            }
    }
};
struct EpiFinal {
    static constexpr bool PERM = true, AFTER_DRAIN = false, IDEMP = false;
    const bf16_t* xb; float* out; const float* gain; float* xslot; unsigned* cnt; unsigned* tmo; PG8_LAS unsigned char* lx;
    __device__ __forceinline__ void operator()(f32x4 (&acc)[2][2][4][2], const Unit& u, int wr, int wc, int fr, int fq) const {
        const int tid = threadIdx.x, lane = tid & 63, wid = __builtin_amdgcn_readfirstlane(tid >> 6);
        PG8_LAS float* P = (PG8_LAS float*)lx; PG8_LAS float* S = (PG8_LAS float*)(lx + 4096); PG8_LAS unsigned* flag = (PG8_LAS unsigned*)(lx + 5120);
        const int rl0 = wr * 64 + fr, col0 = u.pn * BM + wc * 32 + 8 * fq;
#pragma unroll
        for (int ai = 0; ai < 2; ++ai)
#pragma unroll
            for (int m = 0; m < 4; ++m) {
                const int rl = rl0 + ai * HALF + m * 16; const size_t off = (size_t)(u.pm * BM + rl) * 1024 + col0; float ss = 0.f;
#pragma unroll
                for (int bj = 0; bj < 2; ++bj) {
                    const u32x4 b = *(const u32x4*)(xb + off + bj * HALF);
                    const f32x4 o0 = (f32x4){bflo_(b.x), bfhi_(b.x), bflo_(b.y), bfhi_(b.y)} + acc[ai][bj][m][0] * KSC, o1 = (f32x4){bflo_(b.z), bfhi_(b.z), bflo_(b.w), bfhi_(b.w)} + acc[ai][bj][m][1] * KSC;
                    ss += (o0[0] * o0[0] + o0[1] * o0[1]) + (o0[2] * o0[2] + o0[3] * o0[3]) + (o1[0] * o1[0] + o1[1] * o1[1]) + (o1[2] * o1[2] + o1[3] * o1[3]);
                    acc[ai][bj][m][0] = o0; acc[ai][bj][m][1] = o1;
                }
                ss += __shfl_xor(ss, 16); ss += __shfl_xor(ss, 32);
                if (fq == 0) P[rl * 4 + wc] = ss;
            }
        asm volatile("s_waitcnt lgkmcnt(0)" ::: "memory"); __builtin_amdgcn_s_barrier(); asm volatile("" ::: "memory");
        if (tid < 256) { const f32x4 p = *(const PG8_LAS f32x4*)(P + tid * 4);
            __hip_atomic_store(xslot + (size_t)(u.pm * BM + tid) * 4 + u.pn, (p[0] + p[1]) + (p[2] + p[3]), __ATOMIC_RELAXED, __HIP_MEMORY_SCOPE_AGENT); }
        asm volatile("s_waitcnt vmcnt(0)" ::: "memory");
        if (tid < 256 && lane == 0) __hip_atomic_fetch_add(cnt + 64 * u.pm, 1u, __ATOMIC_RELAXED, __HIP_MEMORY_SCOPE_AGENT);
        if (wid == 0) {
            bool dead = false; const unsigned long long t0 = __builtin_amdgcn_s_memrealtime();
            for (;;) {
                if ((unsigned)__builtin_amdgcn_readfirstlane(__hip_atomic_load(cnt + 64 * u.pm, __ATOMIC_RELAXED, __HIP_MEMORY_SCOPE_AGENT)) >= 16u) break;
                if (__builtin_amdgcn_s_memrealtime() - t0 > 2000000ull) { if (lane == 0) __hip_atomic_store(tmo, 1u, __ATOMIC_RELAXED, __HIP_MEMORY_SCOPE_AGENT); dead = true; break; }
                __builtin_amdgcn_s_sleep(2);
            }
            __builtin_amdgcn_fence(__ATOMIC_ACQUIRE, "agent");
            if (lane == 0) flag[0] = dead ? 1u : 0u;
        }
        asm volatile("s_waitcnt vmcnt(0) lgkmcnt(0)" ::: "memory"); __builtin_amdgcn_s_barrier(); asm volatile("" ::: "memory");
        if (tid < 256) { const float* sl = xslot + (size_t)(u.pm * BM + tid) * 4; float q = 0.f;
#pragma unroll
            for (int t = 0; t < 4; ++t) q += __hip_atomic_load(sl + t, __ATOMIC_RELAXED, __HIP_MEMORY_SCOPE_AGENT);
            S[tid] = __builtin_amdgcn_rsqf(q * (1.0f / 1024.0f) + 1e-6f); }
        asm volatile("s_waitcnt lgkmcnt(0)" ::: "memory"); __builtin_amdgcn_s_barrier(); asm volatile("" ::: "memory");
        f32x4 gv[2][2];
#pragma unroll
        for (int bj = 0; bj < 2; ++bj) { gv[bj][0] = *(const f32x4*)(gain + col0 + bj * HALF); gv[bj][1] = *(const f32x4*)(gain + col0 + bj * HALF + 4); }
#pragma unroll
        for (int ai = 0; ai < 2; ++ai)
#pragma unroll
            for (int m = 0; m < 4; ++m) {
                const int rl = rl0 + ai * HALF + m * 16; const float rstd = S[rl]; float* op = out + (size_t)(u.pm * BM + rl) * 1024 + col0;
#pragma unroll
                for (int bj = 0; bj < 2; ++bj) { *(f32x4*)(op + bj * HALF) = acc[ai][bj][m][0] * rstd * gv[bj][0]; *(f32x4*)(op + bj * HALF + 4) = acc[ai][bj][m][1] * rstd * gv[bj][1]; }
            }
    }
};
struct EpiUp {
    static constexpr bool PERM = true, AFTER_DRAIN = false, IDEMP = true;
    bf16_t* z; const PG8_LAS float* rstab;
    __device__ __forceinline__ void operator()(const f32x4 (&acc)[2][2][4][2], const Unit& u, int wr, int wc, int fr, int fq) const {
        const int row0 = u.pm * BM + wr * 64 + fr, col0 = u.pn * BM + wc * 32 + 8 * fq;
        float rs[2][4]; row_rstd(rstab, u, wr, fr, rs);
#pragma unroll
        for (int ai = 0; ai < 2; ++ai)
#pragma unroll
            for (int m = 0; m < 4; ++m) {
                const float r = rs[ai][m]; bf16_t* rowp = z + (size_t)(row0 + ai * HALF + m * 16) * 4096 + col0;
#pragma unroll
                for (int bj = 0; bj < 2; ++bj) {
                    f32x4 a = acc[ai][bj][m][0] * r, b = acc[ai][bj][m][1] * r;
#pragma unroll
                    for (int j = 0; j < 4; ++j) { const float x = fmaxf(a[j], 0.f), y = fmaxf(b[j], 0.f); a[j] = x * x; b[j] = y * y; }
                    st16(rowp + bj * HALF, pack8(a, b));
                }
            }
    }
};
struct EpiIn1 {
    static constexpr bool PERM = true, AFTER_DRAIN = false, IDEMP = false;
    bf16_t* cv; bf16_t* bg; const PG8_LAS float* rstab;
    __device__ __forceinline__ void operator()(const f32x4 (&acc)[2][2][4][2], const Unit& u, int wr, int wc, int fr, int fq) const {
        const int row0 = u.pm * BM + wr * 64 + fr;
        float rs[2][4]; row_rstd(rstab, u, wr, fr, rs);
        if (u.pn < 8) {
            const int col0 = u.pn * 128 + wc * 32 + 8 * fq;
#pragma unroll
            for (int ai = 0; ai < 2; ++ai)
#pragma unroll
                for (int m = 0; m < 4; ++m) {
                    const float r2 = rs[ai][m] * rs[ai][m];
                    st16(cv + (size_t)(row0 + ai * HALF + m * 16) * 1024 + col0, pack8(acc[ai][0][m][0] * acc[ai][1][m][0] * r2, acc[ai][0][m][1] * acc[ai][1][m][1] * r2));
                }
        } else {
            const int col0 = (u.pn - 8) * BM + wc * 32 + 8 * fq;
#pragma unroll
            for (int ai = 0; ai < 2; ++ai)
#pragma unroll
                for (int m = 0; m < 4; ++m) {
                    const float r = rs[ai][m]; bf16_t* rowp = bg + (size_t)(row0 + ai * HALF + m * 16) * 1024 + col0;
#pragma unroll
                    for (int bj = 0; bj < 2; ++bj) st16(rowp + bj * HALF, pack8(acc[ai][bj][m][0] * r, acc[ai][bj][m][1] * r));
                }
        }
    }
};
template <class Epi, class Sched, bool ALIGN_EPI = false, bool SP2 = false>
__device__ __forceinline__ void gemm_phase(PG8_LAS unsigned char* lds, const Gemm g, const Sched& S, const Epi& E) {
    const int tid = threadIdx.x, wid = __builtin_amdgcn_readfirstlane(tid >> 6), lane = tid & 63, wr = wid >> 2, wc = wid & 3, fr = lane & 15, fq = lane >> 4;
    const int K = g.K, nt = K / BK;
    unsigned voffA[2], voffB[2];
#pragma unroll
    for (int i = 0; i < 2; ++i) { int R, C; stage_rc(tid * 16 + i * 8192, R, C); const int Rb = Epi::PERM ? ((R & ~31) + perm32(R & 31)) : R;
        voffA[i] = (unsigned)(R * K + C) * 2u; voffB[i] = (unsigned)(Rb * K + C) * 2u; }
    const size_t kstep = (size_t)(BK * 2);
    const size_t hstep = (size_t)HALF * K * 2;
    const size_t tstep = 2 * hstep;
    const unsigned ldsw = (unsigned)wid * 1024u;
    const int aoff = lds_byte(wr * 64 + fr, fq * 8), boff = lds_byte(wc * 32 + fr, fq * 8);
#define PG8_SA(b, h) (((b) * 2 + (h)) * HTB)
#define PG8_SB(b, h) ((4 + (b) * 2 + (h)) * HTB)
#define PG8_STAGE(bufoff, gbase, voff) do { _Pragma("unroll") for (int _i = 0; _i < 2; ++_i) \
        __builtin_amdgcn_global_load_lds((const unsigned*)((const char*)(gbase) + (voff)[_i]), (PG8_LAS unsigned*)(lds + (bufoff) + ldsw + _i * 8192), 16, 0, 0); } while (0)
#define PG8_LDA(dst, b, h) do { _Pragma("unroll") for (int m = 0; m < 4; ++m) _Pragma("unroll") for (int k = 0; k < 2; ++k) dst[m][k] = *(const PG8_LAS bf16x8*)(lds + PG8_SA(b, h) + aoff + m * 2048 + k * 1024); } while (0)
#define PG8_LDB(dst, b, h) do { _Pragma("unroll") for (int n = 0; n < 2; ++n) _Pragma("unroll") for (int k = 0; k < 2; ++k) dst[n][k] = *(const PG8_LAS bf16x8*)(lds + PG8_SB(b, h) + boff + n * 2048 + k * 1024); } while (0)
#define PG8_MMA(ai, bj, At, Bt) do { __builtin_amdgcn_s_setprio(1); _Pragma("unroll") for (int m = 0; m < 4; ++m) _Pragma("unroll") for (int n = 0; n < 2; ++n) _Pragma("unroll") for (int k = 0; k < 2; ++k) \
        acc[ai][bj][m][n] = __builtin_amdgcn_mfma_f32_16x16x32_bf16(Bt[n][k], At[m][k], acc[ai][bj][m][n], 0, 0, 0); __builtin_amdgcn_s_setprio(0); } while (0)
#define PG8_WAIT_V(n) asm volatile("s_waitcnt vmcnt(" #n ")" ::: "memory")
#define PG8_WAIT_L(n) asm volatile("s_waitcnt lgkmcnt(" #n ")" ::: "memory")
#define PG8_BAR __builtin_amdgcn_s_barrier()
#define PG8_SCHED __builtin_amdgcn_sched_barrier(0)
    Unit cur, nxt; int ui = 0;
    if (!S.next(0, cur)) return;
    f32x4 acc[2][2][4][2];
#pragma unroll
    for (int a = 0; a < 2; ++a)
#pragma unroll
        for (int b = 0; b < 2; ++b)
#pragma unroll
            for (int m = 0; m < 4; ++m)
#pragma unroll
                for (int n = 0; n < 2; ++n) acc[a][b][m][n] = (f32x4){0.f, 0.f, 0.f, 0.f};
    bf16x8 At[4][2], B0[2][2], B1[2][2];
    const char* cA = (const char*)g.A + (size_t)cur.pm * tstep; const char* cB = (const char*)g.Bt + (size_t)cur.pn * tstep;
    S.a_ready(cur);
    if constexpr (SP2) {
        PG8_STAGE(PG8_SB(0, 0), cB, voffB); PG8_STAGE(PG8_SB(0, 1), cB + hstep, voffB); PG8_STAGE(PG8_SA(0, 0), cA, voffA); PG8_STAGE(PG8_SA(0, 1), cA + hstep, voffA);
        if (wr == 1) PG8_BAR;
        PG8_WAIT_V(2); PG8_BAR;
        PG8_STAGE(PG8_SB(1, 0), cB + kstep, voffB); PG8_STAGE(PG8_SA(1, 0), cA + kstep, voffA); PG8_STAGE(PG8_SB(1, 1), cB + hstep + kstep, voffB);
        PG8_WAIT_V(6); PG8_BAR;
    } else {
        PG8_STAGE(PG8_SB(0, 0), cB, voffB); PG8_STAGE(PG8_SA(0, 0), cA, voffA); PG8_STAGE(PG8_SB(0, 1), cB + hstep, voffB); PG8_STAGE(PG8_SA(0, 1), cA + hstep, voffA);
        if (wr == 1) PG8_BAR;
        PG8_WAIT_V(4); PG8_BAR;
        PG8_STAGE(PG8_SB(1, 0), cB + kstep, voffB); PG8_STAGE(PG8_SA(1, 0), cA + kstep, voffA); PG8_STAGE(PG8_SB(1, 1), cB + hstep + kstep, voffB);
        PG8_WAIT_V(6); PG8_BAR;
    }
    for (;;) {
        const bool has_next = S.next(ui + 1, nxt);
        const char* nA = has_next ? (const char*)g.A + (size_t)nxt.pm * tstep : cA; const char* nB = has_next ? (const char*)g.Bt + (size_t)nxt.pn * tstep : cB;
#if !defined(PROBE_KREP)
#define PROBE_KREP 1
#endif
        for (int tt_ = 0; tt_ < nt * PROBE_KREP; tt_ += 2) {
            const int t = tt_ & (nt - 1), t2 = (tt_ + 2) & (nt - 1);
            const bool last = (tt_ == nt * PROBE_KREP - 2);
            const char* a1 = cA + (size_t)(t + 1) * kstep;
            const char* a2 = last ? nA : cA + (size_t)t2 * kstep; const char* b2 = last ? nB : cB + (size_t)t2 * kstep;
            const char* a3 = a2 + kstep; const char* b3 = b2 + kstep;
            if (last && has_next) S.a_ready(nxt);
            if constexpr (SP2) {
            PG8_LDB(B0, 0, 0); PG8_LDB(B1, 0, 1); PG8_SCHED; PG8_LDA(At, 0, 0); PG8_STAGE(PG8_SA(1, 1), a1 + hstep, voffA);
            PG8_WAIT_V(8); PG8_WAIT_L(0); PG8_BAR; PG8_MMA(0, 0, At, B0); PG8_MMA(0, 1, At, B1); PG8_BAR; PG8_SCHED;
            PG8_LDA(At, 0, 1); PG8_STAGE(PG8_SB(0, 0), b2, voffB); PG8_STAGE(PG8_SB(0, 1), b2 + hstep, voffB); PG8_STAGE(PG8_SA(0, 0), a2, voffA);
            PG8_WAIT_V(8); PG8_WAIT_L(0); PG8_BAR; PG8_MMA(1, 0, At, B0); PG8_MMA(1, 1, At, B1); PG8_BAR; PG8_SCHED;
            PG8_LDB(B0, 1, 0); PG8_LDB(B1, 1, 1); PG8_SCHED; PG8_LDA(At, 1, 0); PG8_STAGE(PG8_SA(0, 1), a2 + hstep, voffA);
            PG8_WAIT_V(8); PG8_WAIT_L(0); PG8_BAR; PG8_MMA(0, 0, At, B0); PG8_MMA(0, 1, At, B1); PG8_BAR; PG8_SCHED;
            PG8_LDA(At, 1, 1); PG8_STAGE(PG8_SB(1, 0), b3, voffB); PG8_STAGE(PG8_SB(1, 1), b3 + hstep, voffB); PG8_STAGE(PG8_SA(1, 0), a3, voffA);
            PG8_WAIT_V(8); PG8_WAIT_L(0); PG8_BAR; PG8_MMA(1, 0, At, B0); PG8_MMA(1, 1, At, B1); PG8_BAR; PG8_SCHED;
            } else {
            PG8_LDB(B0, 0, 0); PG8_SCHED; PG8_LDA(At, 0, 0); PG8_STAGE(PG8_SA(1, 1), a1 + hstep, voffA);
            PG8_WAIT_L(8); PG8_BAR; PG8_WAIT_L(0); PG8_MMA(0, 0, At, B0); PG8_BAR; PG8_SCHED;
            PG8_LDB(B1, 0, 1); PG8_STAGE(PG8_SB(0, 0), b2, voffB);
            PG8_BAR; PG8_WAIT_L(0); PG8_MMA(0, 1, At, B1); PG8_BAR;
            PG8_LDA(At, 0, 1); PG8_STAGE(PG8_SA(0, 0), a2, voffA);
            PG8_BAR; PG8_WAIT_L(0); PG8_MMA(1, 0, At, B0); PG8_BAR; PG8_SCHED;
            PG8_STAGE(PG8_SB(0, 1), b2 + hstep, voffB);
            PG8_WAIT_V(6); PG8_BAR; PG8_MMA(1, 1, At, B1); PG8_BAR;
            PG8_LDB(B0, 1, 0); PG8_SCHED; PG8_LDA(At, 1, 0); PG8_STAGE(PG8_SA(0, 1), a2 + hstep, voffA);
            PG8_WAIT_L(8); PG8_BAR; PG8_WAIT_L(0); PG8_MMA(0, 0, At, B0); PG8_BAR; PG8_SCHED;
            PG8_LDB(B1, 1, 1); PG8_STAGE(PG8_SB(1, 0), b3, voffB);
            PG8_BAR; PG8_WAIT_L(0); PG8_MMA(0, 1, At, B1); PG8_BAR;
            PG8_LDA(At, 1, 1); PG8_STAGE(PG8_SA(1, 0), a3, voffA);
            PG8_BAR; PG8_WAIT_L(0); PG8_MMA(1, 0, At, B0); PG8_BAR; PG8_SCHED;
            PG8_STAGE(PG8_SB(1, 1), b3 + hstep, voffB);
            PG8_WAIT_V(6); PG8_BAR; PG8_MMA(1, 1, At, B1); PG8_BAR;
            }
        }
        if constexpr (ALIGN_EPI) { if (wr == 0) PG8_BAR; }
        if constexpr (!Epi::AFTER_DRAIN) { E(acc, cur, wr, wc, fr, fq);
#if defined(PROBE_EPI2)
            if constexpr (Epi::IDEMP) { asm volatile("" ::: "memory"); E(acc, cur, wr, wc, fr, fq); }
#endif
            S.done(cur); }
        if (!has_next) break;
#pragma unroll
        for (int a = 0; a < 2; ++a)
#pragma unroll
            for (int b = 0; b < 2; ++b)
#pragma unroll
                for (int m = 0; m < 4; ++m)
#pragma unroll
                    for (int n = 0; n < 2; ++n) acc[a][b][m][n] = (f32x4){0.f, 0.f, 0.f, 0.f};
        cur = nxt; cA = nA; cB = nB; ++ui;
        if constexpr (ALIGN_EPI) { if (wr == 1) PG8_BAR; }
    }
    PG8_WAIT_V(0);
    if constexpr (!ALIGN_EPI) { if (wr == 0) PG8_BAR; }
    PG8_BAR;
    if constexpr (Epi::AFTER_DRAIN) { E.fused(acc, cur, wr, wc, fr, fq, lds, wid, lane); S.done(cur); }
#undef PG8_SA
#undef PG8_SB
#undef PG8_STAGE
#undef PG8_LDA
#undef PG8_LDB
#undef PG8_MMA
#undef PG8_WAIT_V
#undef PG8_WAIT_L
#undef PG8_BAR
#undef PG8_SCHED
}
}
#ifndef PG8_SP2
#define PG8_SP2 true
#endif
#ifndef PG8_ALIGN
#define PG8_ALIGN true
#endif
constexpr int CW_BAR = 4096;
constexpr int CW_TMO = 0, CW_SEAM = 16384;
#define GAS __attribute__((address_space(1)))
#define LAS __attribute__((address_space(3)))
typedef unsigned short bf16;
typedef unsigned v4u __attribute__((ext_vector_type(4)));
typedef float f32x4 __attribute__((ext_vector_type(4)));
typedef short bf16x8 __attribute__((ext_vector_type(8)));
typedef GAS unsigned gu32;
typedef GAS unsigned long long gu64;
#define RLX_AGENT __ATOMIC_RELAXED, __HIP_MEMORY_SCOPE_AGENT
#define LDS_WAIT() asm volatile("s_waitcnt lgkmcnt(0)" ::: "memory")
#define VM_WAIT() asm volatile("s_waitcnt vmcnt(0)" ::: "memory")
__device__ __forceinline__ unsigned long long rt() { return __builtin_amdgcn_s_memrealtime(); }
__device__ __forceinline__ unsigned f2bf(float f) { unsigned u = __builtin_bit_cast(unsigned, f); return (u + 0x7fffu + ((u >> 16) & 1u)) >> 16; }
__device__ __forceinline__ unsigned pk2(float lo, float hi) { return f2bf(lo) | (f2bf(hi) << 16); }

#define XB_TMO      128
#define XB_XCNT(j)  (256  + 64 * (j))
#define XB_XSUB(j)  (1280 + 64 * (j))
#define XB_XGEN(j)  (2304 + 64 * (j))
#define XB_TOP      3328
#define XB_TOPGEN   3392
#define XCD_BAR_WORDS 3456
#define XB_SPIN_CAP (1u << 18)

__device__ __forceinline__ unsigned xb_ld(unsigned* p)              { return __hip_atomic_load(p, __ATOMIC_RELAXED, __HIP_MEMORY_SCOPE_AGENT); }
__device__ __forceinline__ unsigned xb_add(unsigned* p, unsigned v) { return __hip_atomic_fetch_add(p, v, __ATOMIC_RELAXED, __HIP_MEMORY_SCOPE_AGENT); }
__device__ __forceinline__ unsigned xb_xcc_id() { return (unsigned)__builtin_amdgcn_s_getreg((3 << 11) | 20) & 0xFu; }
#define XB_SPIN(cond, bar) do { unsigned _sp = 0; while (cond) { __builtin_amdgcn_s_sleep(1); \
    if ((++_sp & 255u) == 0u) { if (xb_ld(&(bar)[XB_TMO])) break; if (_sp > XB_SPIN_CAP) { atomicAdd(&(bar)[XB_TMO], 1u); break; } } } } while (0)

struct XcdBarrier {
    unsigned* bar; unsigned x;
    volatile LAS unsigned* st;
};

__device__ __forceinline__ XcdBarrier xcd_barrier_post(unsigned* bar, volatile LAS unsigned* st) {
    XcdBarrier b; b.bar = bar; b.x = xb_xcc_id(); b.st = st;
    if (threadIdx.x == 0) (void)xb_add(&bar[XB_XCNT(b.x)], 1u);
    return b;
}
__device__ __forceinline__ void xcd_barrier_complete(unsigned* bar, unsigned x, unsigned& nloc, unsigned& nx) {
    const unsigned G = gridDim.x * gridDim.y * gridDim.z;
    unsigned sum, cnt, mine, sp = 0u;
    for (;;) {
        sum = 0u; cnt = 0u; mine = 0u;
#pragma unroll
        for (unsigned j = 0; j < 16; ++j) { const unsigned c = xb_ld(&bar[XB_XCNT(j)]); sum += c; cnt += (c > 0u) ? 1u : 0u; mine = (j == x) ? c : mine; }
        if (sum == G) break;
        __builtin_amdgcn_s_sleep(1);
        if ((++sp & 255u) == 0u) { if (xb_ld(&bar[XB_TMO])) break; if (sp > XB_SPIN_CAP) { atomicAdd(&bar[XB_TMO], 1u); break; } }
    }
    nloc = mine > 0u ? mine : 1u; nx = cnt > 0u ? cnt : 1u;
}

__device__ __forceinline__ void xcd_barrier(const XcdBarrier& b) {
    asm volatile("s_waitcnt vmcnt(0)" ::: "memory");
    __syncthreads();
    if (threadIdx.x == 0) {
        unsigned* bar = b.bar;
        __builtin_amdgcn_s_waitcnt(0);
        unsigned nloc = b.st[0], nx = b.st[1];
        if (nloc == 0u) { xcd_barrier_complete(bar, b.x, nloc, nx); b.st[0] = nloc; b.st[1] = nx; }
        const unsigned old = xb_add(&bar[XB_XSUB(b.x)], 1u);
        const unsigned gen = old / nloc;
        if (old + 1u == (gen + 1u) * nloc) {
            __builtin_amdgcn_fence(__ATOMIC_RELEASE, "agent");
            asm volatile("s_waitcnt vmcnt(0)" ::: "memory");
            const unsigned og = xb_add(&bar[XB_TOP], 1u);
            const unsigned tg = og / nx;
            if (og + 1u == (tg + 1u) * nx) xb_add(&bar[XB_TOPGEN], 1u);
            else XB_SPIN(xb_ld(&bar[XB_TOPGEN]) == tg, bar);
            __builtin_amdgcn_fence(__ATOMIC_ACQUIRE, "agent");
            xb_add(&bar[XB_XGEN(b.x)], 1u);
            asm volatile("s_waitcnt vmcnt(0)" ::: "memory");
        } else {
            XB_SPIN(xb_ld(&bar[XB_XGEN(b.x)]) == gen, bar);
            __builtin_amdgcn_fence(__ATOMIC_ACQUIRE, "agent");
            asm volatile("s_waitcnt vmcnt(0)" ::: "memory");
        }
    }
    __syncthreads();
}

constexpr int NWAVES = 8;
#ifndef MK_N_LAUNCHES
#define MK_N_LAUNCHES 1
#endif
#ifndef FUSE_FINAL
#define FUSE_FINAL 0
#endif
constexpr int N_PHASES = FUSE_FINAL ? 12 : 13;
#ifndef PROBE_MASK
#define PROBE_MASK 0
#endif
#define REPS(k) for (int rep_ = 0; rep_ < (((PROBE_MASK) >> (k)) & 1) + 1; ++rep_)
constexpr int N_LAUNCHES = MK_N_LAUNCHES;

constexpr int BATCH = 4, SEQ = 8192, D = 1024, M = BATCH * SEQ, FF = 4096, N_IN0 = 5632, N_IN1 = 3072, NQKV = 4608, CA = 512, CONVW = 31;
constexpr float LOG2E = 1.4426950408889634f, QSCALE = 0.125f * LOG2E, RMS_EPS = 1e-6f, LN_EPS = 1e-5f;

constexpr size_t MiB = 1u << 20;
constexpr size_t WS_CTL = 0, CTL_ZERO_BYTES = 1 * MiB;
constexpr size_t WS_STATS = 1 * MiB;
constexpr size_t WS_BIAS2 = 3 * MiB;
constexpr size_t WS_LSE = 4 * MiB;
constexpr size_t WS_W_IN0 = 8 * MiB, WS_W_OUT0 = 19 * MiB, WS_W_UP0 = 21 * MiB, WS_W_DN0 = 29 * MiB, WS_W_IN1 = 37 * MiB, WS_W_OUT1 = 43 * MiB, WS_W_UP1 = 45 * MiB, WS_W_DN1 = 53 * MiB;
constexpr size_t WS_XB = 64 * MiB;
constexpr size_t WS_R2 = 128 * MiB;
constexpr size_t WS_END = 416 * MiB;
constexpr size_t OUT_OG = 0, OUT_HGLU = 96 * MiB;

constexpr int RING_OFF = 0, RING_BYTES = 131072;
constexpr int AT_K = 0, AT_V = 49152, AT_BT = 98304, AT_WS = 118784, AT_OST = 120832, AT_END = 153600;
constexpr int LDSCTL_OFF = AT_END, MISC_OFF = LDSCTL_OFF + 320;
constexpr int LDS_BYTES = 155648;

struct Frame {
    LAS unsigned char* lds;
    volatile LAS unsigned* MISC;
    gu32* ctl;
    int tid, lane, wave;
    int vcu, G;
};
struct Args { const float* in[17]; float* out; unsigned char* ws; int ph_lo, ph_hi, li, pad; };

__device__ __forceinline__ float wave_sum(float v) {
#pragma unroll
    for (int o = 1; o < 64; o <<= 1) v += __shfl_xor(v, o);
    return v;
}
__device__ __forceinline__ float bf2f(unsigned short b) { return __builtin_bit_cast(float, (unsigned)b << 16); }
__device__ __forceinline__ float bflo(unsigned w) { return __builtin_bit_cast(float, w << 16); }
__device__ __forceinline__ float bfhi(unsigned w) { return __builtin_bit_cast(float, w & 0xffff0000u); }

__device__ __forceinline__ int colmap(int mode, int n0) {
    if (mode == 1) { if (n0 < 512) return 256 * (n0 >> 7) + (n0 & 127); if (n0 < 1024) { const int c = n0 - 512; return 256 * (c >> 7) + 128 + (c & 127); } return n0; }
    if (mode == 2) { if (n0 < 1024) return 2048 + n0; if (n0 < 2048) { const int c = n0 - 1024; return 256 * (c >> 7) + (c & 127); } const int v = n0 - 2048; return 256 * (v >> 7) + 128 + (v & 127); }
    return n0;
}
__device__ __forceinline__ void p0_transpose_item(const float* W, int K, int N, bf16* WT, const float* gain, int mode, LAS float* scr, int item, int lane) {
    const int nblk = N / 64, kb = item / nblk, nb = item % nblk, k0 = 64 * kb, n0 = 64 * nb, r0 = colmap(mode, n0);
    const int lk = lane >> 4, n4 = 4 * (lane & 15);
#pragma unroll 4
    for (int i = 0; i < 16; ++i) { const int kk = 4 * i + lk; const float g = gain ? gain[k0 + kk] : 1.0f; const f32x4 v = *(const GAS f32x4*)(W + (size_t)(k0 + kk) * N + n0 + n4);
        LAS float* d = scr + kk * 65 + n4; d[0] = g * v.x; d[1] = g * v.y; d[2] = g * v.z; d[3] = g * v.w; }
    LDS_WAIT(); asm volatile("" ::: "memory");
    const int c = lane & 7;
#pragma unroll
    for (int j = 0; j < 8; ++j) { const int n = (lane >> 3) + 8 * j; const LAS float* s = scr + (8 * c) * 65 + n;
        v4u o; o.x = pk2(s[0 * 65], s[1 * 65]); o.y = pk2(s[2 * 65], s[3 * 65]); o.z = pk2(s[4 * 65], s[5 * 65]); o.w = pk2(s[6 * 65], s[7 * 65]);
        *(GAS v4u*)(WT + (size_t)(r0 + n) * K + k0 + 8 * c) = o; }
    LDS_WAIT(); asm volatile("" ::: "memory");
}
__device__ __forceinline__ void p0_x_item(const float* x, bf16* xb, float* stats, int item, int lane) {
#pragma unroll
    for (int rr = 0; rr < 4; ++rr) { const int m = 4 * item + rr; float s = 0.f;
#pragma unroll
        for (int hh = 0; hh < 2; ++hh) { const float* p = x + (size_t)m * D + 512 * hh + 8 * lane; const f32x4 a = *(const GAS f32x4*)p, b = *(const GAS f32x4*)(p + 4);
            s += (a.x * a.x + a.y * a.y) + (a.z * a.z + a.w * a.w) + (b.x * b.x + b.y * b.y) + (b.z * b.z + b.w * b.w);
            v4u o; o.x = pk2(a.x, a.y); o.y = pk2(a.z, a.w); o.z = pk2(b.x, b.y); o.w = pk2(b.z, b.w); *(GAS v4u*)(xb + (size_t)m * D + 512 * hh + 8 * lane) = o; }
        s = wave_sum(s);
        if (lane < 16) stats[(size_t)m * 16 + lane] = lane == 0 ? s : 0.f; }
}
__device__ __forceinline__ void p0_prologue(Frame& F, const Args& a) {
    unsigned char* ws = a.ws;
    LAS float* scr = (LAS float*)(F.lds + RING_OFF + F.wave * 16640);
    const int gw = F.vcu * NWAVES + F.wave, NGW = F.G * NWAVES;
    constexpr int I_IN0 = (D / 64) * (N_IN0 / 64), I_SQ = (D / 64) * (D / 64), I_UP = (D / 64) * (FF / 64), I_DN = (FF / 64) * (D / 64), I_IN1 = (D / 64) * (N_IN1 / 64);
    constexpr int NW_ITEMS = I_IN0 + 2 * I_SQ + 2 * I_UP + 2 * I_DN + I_IN1, NITEMS = NW_ITEMS + M / 4;
    const float* x = a.in[0]; bf16* xb = (bf16*)(ws + WS_XB); float* stats = (float*)(ws + WS_STATS);
    for (int it = gw; it < NITEMS; it += NGW) {
        int r = it;
        if (r >= NW_ITEMS) { p0_x_item(x, xb, stats, r - NW_ITEMS, F.lane); continue; }
        if (r < I_IN0) { p0_transpose_item(a.in[3], D, N_IN0, (bf16*)(ws + WS_W_IN0), a.in[2], 1, scr, r, F.lane); continue; } r -= I_IN0;
        if (r < I_SQ) { p0_transpose_item(a.in[8], D, D, (bf16*)(ws + WS_W_OUT0), nullptr, 0, scr, r, F.lane); continue; } r -= I_SQ;
        if (r < I_UP) { p0_transpose_item(a.in[14], D, FF, (bf16*)(ws + WS_W_UP0), a.in[13], 0, scr, r, F.lane); continue; } r -= I_UP;
        if (r < I_DN) { p0_transpose_item(a.in[15], FF, D, (bf16*)(ws + WS_W_DN0), nullptr, 0, scr, r, F.lane); continue; } r -= I_DN;
        if (r < I_IN1) { p0_transpose_item(a.in[10], D, N_IN1, (bf16*)(ws + WS_W_IN1), a.in[9], 2, scr, r, F.lane); continue; } r -= I_IN1;
        if (r < I_SQ) { p0_transpose_item(a.in[12], D, D, (bf16*)(ws + WS_W_OUT1), nullptr, 0, scr, r, F.lane); continue; } r -= I_SQ;
        if (r < I_UP) { p0_transpose_item(a.in[14] + (size_t)D * FF, D, FF, (bf16*)(ws + WS_W_UP1), a.in[13] + D, 0, scr, r, F.lane); continue; } r -= I_UP;
        p0_transpose_item(a.in[15] + (size_t)FF * D, FF, D, (bf16*)(ws + WS_W_DN1), nullptr, 0, scr, r, F.lane);
    }
    if (blockIdx.x == 0) {
        float* b2 = (float*)(ws + WS_BIAS2); const float* rb = a.in[1];
        for (int i = F.tid; i < 24 * 129; i += NWAVES * 64) {
            const int gh = i / 129, m = i % 129, g = gh >> 3, n = m << (2 * g);
            int bucket = n;
            if (n >= 16) { const float nf = (float)n; const int large = 16 + (int)(logf(nf / 16.0f) / logf(128.0f) * 16.0f); bucket = large < 31 ? large : 31; }
            b2[gh * 132 + m] = LOG2E * rb[bucket * 24 + gh];
        }
    }
}

typedef float f32x16 __attribute__((ext_vector_type(16)));
typedef short s16x4 __attribute__((ext_vector_type(4)));
typedef short v4i16_t __attribute__((ext_vector_type(4)));
__device__ __forceinline__ int crow(int r, int hi) { return (r & 3) + 8 * (r >> 2) + 4 * hi; }
__device__ __forceinline__ s16x4 vtr(const LAS unsigned char* p) { return __builtin_bit_cast(s16x4, __builtin_amdgcn_ds_read_tr16_b64_v4i16((LAS v4i16_t*)p)); }
__device__ __forceinline__ unsigned cvtpk_s(float lo, float hi) { typedef float f2 __attribute__((ext_vector_type(2))); typedef __bf16 b2 __attribute__((ext_vector_type(2))); f2 v = {lo, hi}; b2 b = __builtin_convertvector(v, b2); return __builtin_bit_cast(unsigned, b); }
constexpr int ATT_UNITS = BATCH * 3 * 8 * 32;
__device__ __forceinline__ void glds16(const void* gsrc, unsigned lds_dst) { unsigned keep;
    asm volatile("s_mov_b32 %0, m0\n\ts_mov_b32 m0, %2\n\ts_nop 0\n\tglobal_load_lds_dwordx4 %1, off\n\ts_mov_b32 m0, %0" : "=&s"(keep) : "v"(gsrc), "s"(lds_dst) : "memory"); }
struct AttUnit { const bf16* Qb; const bf16* Kb; const bf16* Vb; size_t rowbase; int g, h, gh, d, j0; };
__device__ __forceinline__ AttUnit att_decode(int u, const bf16* qkv) {
    AttUnit t; const int rb = u & 31, b = u / 768; t.h = (u >> 5) & 7; t.g = (u >> 8) % 3; t.gh = t.g * 8 + t.h;
    t.d = 1 << (2 * t.g); const int lgn = 5 - 2 * t.g, r = rb >> lgn; t.j0 = (rb & ((1 << lgn) - 1)) * 256;
    t.rowbase = (size_t)b * SEQ + r;
    t.Qb = qkv + ((size_t)((t.gh * 4 + b) * 8192 + r * (SEQ >> (2 * t.g))) << 6);
    t.Kb = t.Qb + (size_t)24 * 4 * 8192 * 64; t.Vb = t.Kb + (size_t)24 * 4 * 8192 * 64; return t;
}
__device__ __forceinline__ void att_issue_k(const AttUnit& t, unsigned kl, int wave, int lane) {
#pragma unroll
    for (int k = 0; k < 6; ++k) {
        const int inst = wave * 6 + k, tr = 8 * inst + (lane >> 3); int kj = t.j0 - 128 + tr; kj = kj < 0 ? 0 : kj;
        const int c = (lane & 7) ^ ((tr >> 1) & 7);
        glds16(t.Kb + kj * 64 + c * 8, (unsigned)__builtin_amdgcn_readfirstlane((int)(kl + inst * 1024)));
    }
}
__device__ __forceinline__ void att_issue_v(const AttUnit& t, unsigned vl, int wave, int lane) {
#pragma unroll
    for (int k = 0; k < 6; ++k) {
        const int inst = wave * 6 + k, dh = inst / 24, kg = inst % 24, tr = 16 * kg + (lane >> 2); int kj = t.j0 - 128 + tr; kj = kj < 0 ? 0 : kj;
        glds16(t.Vb + kj * 64 + ((lane & 3) + 4 * dh) * 8, (unsigned)__builtin_amdgcn_readfirstlane((int)(vl + inst * 1024)));
    }
}
__device__ __forceinline__ void p2_attention(Frame& F, const Args& a) {
    const bf16* qkv = (const bf16*)(a.ws + WS_R2); bf16* og = (bf16*)((unsigned char*)a.out + OUT_OG); float* lse = (float*)(a.ws + WS_LSE); const float* b2 = (const float*)(a.ws + WS_BIAS2);
    LAS unsigned char* const KL = F.lds + AT_K; LAS unsigned char* const VL = F.lds + AT_V; LAS float* const BT = (LAS float*)(F.lds + AT_BT);
    LAS float* const wsf = (LAS float*)(F.lds + AT_WS) + F.wave * 64; LAS bf16* const stg = (LAS bf16*)(F.lds + AT_OST) + F.wave * 2048;
    const unsigned kl = (unsigned)(uintptr_t)KL, vl = (unsigned)(uintptr_t)VL;
    const int lane = F.lane, wave = F.wave, r32 = lane & 31, hi = lane >> 5;
    const int upw = (ATT_UNITS + F.G - 1) / F.G, u0 = F.vcu * upw;
    int nu = ATT_UNITS - u0; nu = nu < 0 ? 0 : (nu > upw ? upw : nu);
    if (nu == 0) return;
    int prev_gh = -1;
    const int vlane = ((lane >> 4) & 1) * 32 + (lane & 3) * 8 + (4 * hi + ((lane & 15) >> 2)) * 64;
    AttUnit cur = att_decode(u0, qkv);
    att_issue_k(cur, kl, wave, lane);
    pg8::bf16x8 qn[4];
    { const bf16* qp = cur.Qb + (cur.j0 + 32 * wave + r32) * 64 + hi * 8;
#pragma unroll
      for (int d0 = 0; d0 < 4; ++d0) qn[d0] = *(const pg8::bf16x8*)(qp + d0 * 16); }
    asm volatile("" : "+v"(qn[0]), "+v"(qn[1]), "+v"(qn[2]), "+v"(qn[3]));
    for (int i = 0; i < nu; ++i) {
        const bool has_next = (i + 1 < nu);
        const AttUnit nxt = att_decode(has_next ? u0 + i + 1 : u0 + i, qkv);
        const int g = cur.g, h = cur.h, d = cur.d, j0 = cur.j0; const size_t rowbase = cur.rowbase;
        if (cur.gh != prev_gh) {
            prev_gh = cur.gh;
            for (int e = F.tid; e < 5 * 4 * 64 * 4; e += NWAVES * 64) {
                const int ii = e & 3, L = (e >> 2) & 63, r4 = (e >> 8) & 3, kb = e >> 10, q = L & 31, hh = L >> 5;
                const int m = 128 - 32 * kb + q - (8 * r4 + 4 * hh + ii);
                BT[e] = (m >= 0 && m <= 128) ? b2[cur.gh * 132 + m] : -1e30f;
            }
        }
        asm volatile("s_waitcnt vmcnt(0) lgkmcnt(0)\n\ts_barrier" ::: "memory");
        att_issue_v(cur, vl, wave, lane);
        pg8::bf16x8 qr[4];
#pragma unroll
        for (int d0 = 0; d0 < 4; ++d0) qr[d0] = qn[d0];
        if (has_next) { const bf16* qp = nxt.Qb + (nxt.j0 + 32 * wave + r32) * 64 + hi * 8;
#pragma unroll
            for (int d0 = 0; d0 < 4; ++d0) qn[d0] = *(const pg8::bf16x8*)(qp + d0 * 16); }
        f32x16 S[5];
        const bool first = (j0 == 0);
#pragma unroll
        for (int kb = 0; kb < 5; ++kb) {
            f32x16 acc;
#pragma unroll
            for (int r4 = 0; r4 < 4; ++r4) { const f32x4 t = *(const LAS f32x4*)(BT + ((kb * 4 + r4) * 64 + lane) * 4); acc[4 * r4 + 0] = t[0]; acc[4 * r4 + 1] = t[1]; acc[4 * r4 + 2] = t[2]; acc[4 * r4 + 3] = t[3]; }
            const int trow = 32 * (wave + kb) + r32;
#pragma unroll
            for (int d0 = 0; d0 < 4; ++d0) {
                const pg8::bf16x8 kf = *(const LAS pg8::bf16x8*)(KL + trow * 128 + (((2 * d0 + hi) ^ ((trow >> 1) & 7)) << 4));
                acc = __builtin_amdgcn_mfma_f32_32x32x16_bf16(kf, qr[d0], acc, 0, 0, 0);
            }
            if (first && kb < 4 - wave) {
#pragma unroll
                for (int rr = 0; rr < 16; ++rr) acc[rr] = -1e30f;
            }
            S[kb] = acc;
        }
        float mx = S[0][0];
#pragma unroll
        for (int kb = 0; kb < 5; ++kb)
#pragma unroll
            for (int rr = 0; rr < 16; ++rr) mx = fmaxf(mx, S[kb][rr]);
        { auto sw = __builtin_amdgcn_permlane32_swap(__float_as_uint(mx), __float_as_uint(mx), false, false); mx = fmaxf(__uint_as_float(sw[0]), __uint_as_float(sw[1])); }
        float lsum = 0.f;
#pragma unroll
        for (int kb = 0; kb < 5; ++kb)
#pragma unroll
            for (int rr = 0; rr < 16; ++rr) { const float p = __builtin_amdgcn_exp2f(S[kb][rr] - mx); S[kb][rr] = p; lsum += p; }
        { auto sw = __builtin_amdgcn_permlane32_swap(__float_as_uint(lsum), __float_as_uint(lsum), false, false); lsum = __uint_as_float(sw[0]) + __uint_as_float(sw[1]); }
        asm volatile("" : "+v"(qn[0]), "+v"(qn[1]), "+v"(qn[2]), "+v"(qn[3]));
        asm volatile("s_waitcnt lgkmcnt(0)\n\ts_barrier" ::: "memory");
        if (has_next) { att_issue_k(nxt, kl, wave, lane); asm volatile("s_waitcnt vmcnt(6)\n\ts_barrier" ::: "memory"); }
        else asm volatile("s_waitcnt vmcnt(0)\n\ts_barrier" ::: "memory");
        f32x16 o[2]; o[0] = f32x16{}; o[1] = f32x16{};
#pragma unroll
        for (int kb = 0; kb < 5; ++kb)
#pragma unroll
            for (int s = 0; s < 2; ++s) {
                v4u pw; pw.x = cvtpk_s(S[kb][8 * s + 0], S[kb][8 * s + 1]); pw.y = cvtpk_s(S[kb][8 * s + 2], S[kb][8 * s + 3]); pw.z = cvtpk_s(S[kb][8 * s + 4], S[kb][8 * s + 5]); pw.w = cvtpk_s(S[kb][8 * s + 6], S[kb][8 * s + 7]);
                const pg8::bf16x8 pa = __builtin_bit_cast(pg8::bf16x8, pw);
                const int kg = 2 * (wave + kb) + s;
#pragma unroll
                for (int d0 = 0; d0 < 2; ++d0) {
                    const LAS unsigned char* vp = VL + (d0 * 24 + kg) * 1024 + vlane;
                    const s16x4 lo = vtr(vp), hh = vtr(vp + 512);
                    const pg8::bf16x8 vb = (pg8::bf16x8){lo[0], lo[1], lo[2], lo[3], hh[0], hh[1], hh[2], hh[3]};
                    o[d0] = __builtin_amdgcn_mfma_f32_32x32x16_bf16(pa, vb, o[d0], 0, 0, 0);
                }
            }
        if (hi == 0) { wsf[r32] = __builtin_amdgcn_rcpf(lsum); lse[((size_t)g * M + rowbase + (size_t)d * (j0 + 32 * wave + r32)) * 8 + h] = mx + __builtin_amdgcn_logf(lsum); }
        asm volatile("s_waitcnt lgkmcnt(0)" ::: "memory");
#pragma unroll
        for (int rr = 0; rr < 16; ++rr) { const int orow = crow(rr, hi); const float il = wsf[orow];
            stg[orow * 64 + r32] = (bf16)f2bf(o[0][rr] * il); stg[orow * 64 + 32 + r32] = (bf16)f2bf(o[1][rr] * il); }
        asm volatile("s_waitcnt lgkmcnt(0)" ::: "memory");
        bf16* ob = og + (size_t)g * M * 512 + h * 64;
#pragma unroll
        for (int k = 0; k < 4; ++k) { const int row = k * 8 + (lane >> 3), ch = lane & 7; const v4u v = *(const LAS v4u*)(stg + row * 64 + ch * 8);
            *(v4u*)(ob + (rowbase + (size_t)d * (j0 + 32 * wave + row)) * 512 + ch * 8) = v; }
        asm volatile("s_waitcnt lgkmcnt(0)" ::: "memory");
        cur = nxt;
    }
    asm volatile("s_waitcnt vmcnt(0) lgkmcnt(0)\n\ts_barrier" ::: "memory");
}

constexpr int P3_TB = 32, P3_ROWS = P3_TB + CONVW - 1, P3_DT = 0, P3_WT = 65536, P3_UNITS = M / P3_TB;
typedef float f32x2 __attribute__((ext_vector_type(2)));
__device__ __forceinline__ void p3_conv_cat(Frame& F, const Args& a) {
    const bf16* hg = (const bf16*)((unsigned char*)a.out + OUT_HGLU); const bf16* yb = (const bf16*)((unsigned char*)a.out + OUT_OG); const float* lse = (const float*)(a.ws + WS_LSE); bf16* cat = (bf16*)(a.ws + WS_R2);
    const float* cw = a.in[4]; const float* cb = a.in[5]; const float* lg = a.in[6]; const float* lb = a.in[7];
    const int lane = F.lane, wave = F.wave, c0 = 8 * lane;
    LAS unsigned char* const DT = F.lds + P3_DT; LAS unsigned char* const WT = F.lds + P3_WT;
    for (int j = wave; j < 2 * CONVW; j += NWAVES)
        __builtin_amdgcn_global_load_lds((const unsigned*)(cw + (j >> 1) * CA + c0 + 4 * (j & 1)), (LAS unsigned*)(WT + j * 1024), 16, 0, 0);
    f32x2 bias2v[4], gam[4], bet[4];
#pragma unroll
    for (int q = 0; q < 4; ++q) { bias2v[q] = *(const f32x2*)(cb + c0 + 2 * q); gam[q] = *(const f32x2*)(lg + c0 + 2 * q); bet[q] = *(const f32x2*)(lb + c0 + 2 * q); }
    const int upw = (P3_UNITS + F.G - 1) / F.G;
    for (int i = 0; i < upw; ++i) {
        const int u = F.vcu * upw + i; if (u >= P3_UNITS) break;
        const int t0 = u * P3_TB, ts = t0 & (SEQ - 1);
        for (int r = wave; r < P3_ROWS; r += NWAVES) {
            if (ts - (CONVW - 1) + r >= 0) __builtin_amdgcn_global_load_lds((const unsigned*)(hg + (size_t)(t0 - (CONVW - 1) + r) * CA + c0), (LAS unsigned*)(DT + r * 1024), 16, 0, 0);
            else *(LAS v4u*)(DT + r * 1024 + lane * 16) = (v4u){0u, 0u, 0u, 0u};
        }
        const int hh = lane >> 3; float l3[4][3]; v4u og3[4][3];
#pragma unroll
        for (int j = 0; j < 4; ++j) { const size_t row = (size_t)t0 + 4 * wave + j;
#pragma unroll
            for (int g = 0; g < 3; ++g) { l3[j][g] = lse[((size_t)g * M + row) * 8 + hh]; og3[j][g] = *(const v4u*)(yb + ((size_t)g * M + row) * 512 + c0); } }
        asm volatile("s_waitcnt vmcnt(0)" ::: "memory");
        __syncthreads();
        f32x2 acc[4][4];
#pragma unroll
        for (int j = 0; j < 4; ++j)
#pragma unroll
            for (int q = 0; q < 4; ++q) acc[j][q] = bias2v[q];
        f32x2 wv[4][4];
#pragma unroll
        for (int r = 0; r < P3_TB / NWAVES + CONVW - 1; ++r) {
            const v4u d = *(const LAS v4u*)(DT + (4 * wave + r) * 1024 + lane * 16);
            const f32x2 x0 = {bflo(d.x), bfhi(d.x)}, x1 = {bflo(d.y), bfhi(d.y)}, x2 = {bflo(d.z), bfhi(d.z)}, x3 = {bflo(d.w), bfhi(d.w)};
            if (r < CONVW) { const f32x4 w0 = *(const LAS f32x4*)(WT + (2 * r) * 1024 + lane * 16), w1 = *(const LAS f32x4*)(WT + (2 * r + 1) * 1024 + lane * 16);
                wv[r & 3][0] = (f32x2){w0[0], w0[1]}; wv[r & 3][1] = (f32x2){w0[2], w0[3]}; wv[r & 3][2] = (f32x2){w1[0], w1[1]}; wv[r & 3][3] = (f32x2){w1[2], w1[3]}; }
#pragma unroll
            for (int j = 0; j < 4; ++j) { const int k = r - j;
                if (k >= 0 && k < CONVW) { acc[j][0] += wv[k & 3][0] * x0; acc[j][1] += wv[k & 3][1] * x1; acc[j][2] += wv[k & 3][2] * x2; acc[j][3] += wv[k & 3][3] * x3; } }
        }
#pragma unroll
        for (int j = 0; j < 4; ++j) {
            const size_t row = (size_t)t0 + 4 * wave + j;
            float s = (acc[j][0][0] + acc[j][0][1]) + (acc[j][1][0] + acc[j][1][1]) + (acc[j][2][0] + acc[j][2][1]) + (acc[j][3][0] + acc[j][3][1]);
            const float mu = wave_sum(s) * (1.0f / CA); float qq = 0.f;
#pragma unroll
            for (int q = 0; q < 4; ++q) { acc[j][q] -= mu; qq += acc[j][q][0] * acc[j][q][0] + acc[j][q][1] * acc[j][q][1]; }
            const float rstd = __builtin_amdgcn_rsqf(wave_sum(qq) * (1.0f / CA) + LN_EPS);
            float y[8];
#pragma unroll
            for (int q = 0; q < 4; ++q) { const f32x2 v = acc[j][q] * rstd * gam[q] + bet[q];
                y[2 * q] = v[0] * __builtin_amdgcn_rcpf(1.0f + __builtin_amdgcn_exp2f(-LOG2E * v[0])); y[2 * q + 1] = v[1] * __builtin_amdgcn_rcpf(1.0f + __builtin_amdgcn_exp2f(-LOG2E * v[1])); }
            v4u o; o.x = pk2(y[0], y[1]); o.y = pk2(y[2], y[3]); o.z = pk2(y[4], y[5]); o.w = pk2(y[6], y[7]);
            *(v4u*)(cat + row * D + c0) = o;
            const float lm = fmaxf(l3[j][0], fmaxf(l3[j][1], l3[j][2])); float w0 = __builtin_amdgcn_exp2f(l3[j][0] - lm), w1 = __builtin_amdgcn_exp2f(l3[j][1] - lm), w2 = __builtin_amdgcn_exp2f(l3[j][2] - lm);
            const float iw = __builtin_amdgcn_rcpf(w0 + w1 + w2); w0 *= iw; w1 *= iw; w2 *= iw;
            const v4u a0 = og3[j][0], a1 = og3[j][1], a2 = og3[j][2]; v4u rr;
            rr.x = pk2(w0 * bflo(a0.x) + w1 * bflo(a1.x) + w2 * bflo(a2.x), w0 * bfhi(a0.x) + w1 * bfhi(a1.x) + w2 * bfhi(a2.x));
            rr.y = pk2(w0 * bflo(a0.y) + w1 * bflo(a1.y) + w2 * bflo(a2.y), w0 * bfhi(a0.y) + w1 * bfhi(a1.y) + w2 * bfhi(a2.y));
            rr.z = pk2(w0 * bflo(a0.z) + w1 * bflo(a1.z) + w2 * bflo(a2.z), w0 * bfhi(a0.z) + w1 * bfhi(a1.z) + w2 * bfhi(a2.z));
            rr.w = pk2(w0 * bflo(a0.w) + w1 * bflo(a1.w) + w2 * bflo(a2.w), w0 * bfhi(a0.w) + w1 * bfhi(a1.w) + w2 * bfhi(a2.w));
            *(v4u*)(cat + row * D + CA + c0) = rr;
        }
        asm volatile("s_waitcnt lgkmcnt(0)" ::: "memory");
        __syncthreads();
    }
}

__device__ __forceinline__ void p8_shortconv(Frame& F, const Args& a) {
    const bf16* bg = (const bf16*)(a.ws + WS_R2); const bf16* cv = (const bf16*)(a.ws + WS_R2 + 64 * MiB); bf16* y = (bf16*)(a.ws + WS_R2 + 128 * MiB);
    const float* w = a.in[11];
    const int c0 = 8 * (F.tid & 127), rsub = F.tid >> 7;
    f32x2 wk[3][4];
#pragma unroll
    for (int k = 0; k < 3; ++k)
#pragma unroll
        for (int q = 0; q < 4; ++q) wk[k][q] = *(const f32x2*)(w + k * D + c0 + 2 * q);
    constexpr int NU = M / 32; const int upw = (NU + F.G - 1) / F.G;
    for (int i = 0; i < upw; ++i) {
        const int u = F.vcu * upw + i; if (u >= NU) break;
        const int r0 = u * 32 + rsub * 8, t = r0 & (SEQ - 1);
        v4u xc[10], xb8[8];
#pragma unroll
        for (int j = 0; j < 10; ++j) xc[j] = (t + j - 2 >= 0) ? *(const v4u*)(cv + (size_t)(r0 + j - 2) * D + c0) : (v4u){0u, 0u, 0u, 0u};
#pragma unroll
        for (int j = 0; j < 8; ++j) xb8[j] = *(const v4u*)(bg + (size_t)(r0 + j) * D + c0);
#pragma unroll
        for (int j = 0; j < 8; ++j) {
            f32x2 acc[4] = {{0.f, 0.f}, {0.f, 0.f}, {0.f, 0.f}, {0.f, 0.f}};
#pragma unroll
            for (int k = 0; k < 3; ++k) { const v4u x = xc[j + k];
                acc[0] += wk[k][0] * (f32x2){bflo(x.x), bfhi(x.x)}; acc[1] += wk[k][1] * (f32x2){bflo(x.y), bfhi(x.y)}; acc[2] += wk[k][2] * (f32x2){bflo(x.z), bfhi(x.z)}; acc[3] += wk[k][3] * (f32x2){bflo(x.w), bfhi(x.w)}; }
            const v4u b = xb8[j];
            v4u o; o.x = pk2(acc[0][0] * bflo(b.x), acc[0][1] * bfhi(b.x)); o.y = pk2(acc[1][0] * bflo(b.y), acc[1][1] * bfhi(b.y)); o.z = pk2(acc[2][0] * bflo(b.z), acc[2][1] * bfhi(b.z)); o.w = pk2(acc[3][0] * bflo(b.w), acc[3][1] * bfhi(b.w));
            *(v4u*)(y + (size_t)(r0 + j) * D + c0) = o;
        }
    }
}

__device__ __forceinline__ void p12_final_norm(Frame& F, const Args& a) {
    const float* stats = (const float*)(a.ws + WS_STATS); const bf16* xb = (const bf16*)(a.ws + WS_XB); const float* g = a.in[16]; float* out = a.out;
    const int gw = F.vcu * NWAVES + F.wave, NGW = F.G * NWAVES;
    f32x4 gv[4];
#pragma unroll
    for (int j = 0; j < 4; ++j) gv[j] = *(const f32x4*)(g + 8 * F.lane + 512 * (j >> 1) + 4 * (j & 1));
    for (int row = gw; row < M; row += NGW) {
        float s = stats[(size_t)row * 16 + (F.lane & 15)];
        s += __shfl_xor(s, 1); s += __shfl_xor(s, 2); s += __shfl_xor(s, 4); s += __shfl_xor(s, 8);
        const float rstd = 1.0f / sqrtf(s * (1.0f / D) + RMS_EPS);
#pragma unroll
        for (int j = 0; j < 2; ++j) {
            const v4u w = *(const v4u*)(xb + (size_t)row * D + 8 * F.lane + 512 * j);
            const f32x4 v0 = (f32x4){bflo(w.x), bfhi(w.x), bflo(w.y), bfhi(w.y)}, v1 = (f32x4){bflo(w.z), bfhi(w.z), bflo(w.w), bfhi(w.w)};
            float* o = out + (size_t)row * D + 8 * F.lane + 512 * j;
            *(f32x4*)o = v0 * rstd * gv[2 * j]; *(f32x4*)(o + 4) = v1 * rstd * gv[2 * j + 1];
        }
    }
}

constexpr int RSTAB_OFF = RING_BYTES;
__device__ __forceinline__ void rstab_fill(Frame& F, const pg8::StaticOrder& S, const float* stats) {
    LAS float* tab = (LAS float*)(F.lds + RSTAB_OFF); pg8::Unit u;
    if (F.tid < 256)
        for (int i = 0; S.next(i, u); ++i) {
            const f32x4* p = (const f32x4*)(stats + (size_t)(u.pm * 256 + F.tid) * 16);
            const f32x4 a = p[0], b = p[1], c = p[2], d = p[3];
            const float s = ((a[0] + a[1]) + (a[2] + a[3])) + ((b[0] + b[1]) + (b[2] + b[3])) + ((c[0] + c[1]) + (c[2] + c[3])) + ((d[0] + d[1]) + (d[2] + d[3]));
            tab[i * 256 + F.tid] = __builtin_amdgcn_rsqf(s * (1.0f / D) + RMS_EPS) * pg8::KSC;
        }
    __syncthreads();
}
#ifndef STAG_TICKS
#define STAG_TICKS 0
#endif
__device__ __forceinline__ void stagger(int ticks) {
    if (ticks > 0 && ((blockIdx.x >> 3) & 1)) { const unsigned long long t0 = __builtin_amdgcn_s_memrealtime(); while (__builtin_amdgcn_s_memrealtime() - t0 < (unsigned long long)ticks) __builtin_amdgcn_s_sleep(32); }
}
__global__ void __launch_bounds__(NWAVES * 64, 2) hybrid_fwd(Args args) {
    extern __shared__ __attribute__((aligned(16))) unsigned char lds[];
    Frame F;
    F.lds = (LAS unsigned char*)lds;
    F.MISC = (volatile LAS unsigned*)(F.lds + MISC_OFF);
    F.tid = threadIdx.x; F.lane = F.tid & 63; F.wave = __builtin_amdgcn_readfirstlane(F.tid >> 6);
    F.G = gridDim.x; { const int bx = blockIdx.x; F.vcu = (F.G % 8 == 0) ? (bx % 8) * (F.G / 8) + bx / 8 : bx; }
    unsigned char* ws = args.ws;
    F.ctl = (gu32*)(ws + WS_CTL);
    for (int u = F.tid; u < (LDS_BYTES - LDSCTL_OFF) / 4; u += NWAVES * 64) ((LAS unsigned*)(F.lds + LDSCTL_OFF))[u] = 0u;
    __syncthreads();
    XcdBarrier bar; bar.bar = (unsigned*)(F.ctl + CW_BAR); bar.x = 0; bar.st = nullptr;
    if (N_LAUNCHES == 1) bar = xcd_barrier_post((unsigned*)(F.ctl + CW_BAR), F.MISC + 8);
#ifndef PROBE_BAR2
#define PROBE_BAR2 0
#endif
#define GRID_BAR() do { if (N_LAUNCHES == 1) { xcd_barrier(bar); if (PROBE_BAR2) xcd_barrier(bar); } } while (0)
    const int lo = args.ph_lo, hi = args.ph_hi;
#define IN(k) (lo <= (k) && (k) < hi)
#define BOTH(k) (IN(k) && IN((k) + 1))
    bf16* const xb = (bf16*)(ws + WS_XB); float* const stats = (float*)(ws + WS_STATS);
    bf16* const r2 = (bf16*)(ws + WS_R2);

    if (IN(0)) { REPS(0) { p0_prologue(F, args); } if (BOTH(0)) GRID_BAR(); }
    if (IN(1)) {
        stagger(STAG_TICKS);
        REPS(1) {
        pg8::Gemm g{xb, (const bf16*)(ws + WS_W_IN0), M, N_IN0, D}; pg8::StaticOrder S; S.init(M, N_IN0, F.G, (int)blockIdx.x);
        rstab_fill(F, S, stats);
        pg8::EpiIn0 E{(bf16*)((unsigned char*)args.out + OUT_HGLU), r2, (const LAS float*)(F.lds + RSTAB_OFF), QSCALE};
        pg8::gemm_phase<pg8::EpiIn0, pg8::StaticOrder, PG8_ALIGN, PG8_SP2>(F.lds + RING_OFF, g, S, E);
        }
        if (BOTH(1)) GRID_BAR();
    }
    if (IN(2)) { REPS(2) { p2_attention(F, args); } if (BOTH(2)) GRID_BAR(); }
    if (IN(3)) { REPS(3) { p3_conv_cat(F, args); } if (BOTH(3)) GRID_BAR(); }
    if (IN(4)) {
        REPS(4) {
        pg8::Gemm g{r2, (const bf16*)(ws + WS_W_OUT0), M, D, D}; pg8::StaticOrder S; S.init(M, D, F.G, (int)blockIdx.x);
        pg8::EpiRes E{xb, stats};
        pg8::gemm_phase<pg8::EpiRes, pg8::StaticOrder, PG8_ALIGN, PG8_SP2>(F.lds + RING_OFF, g, S, E);
        }
        if (BOTH(4)) GRID_BAR();
    }
    if (IN(5)) {
        stagger(STAG_TICKS);
        REPS(5) {
        pg8::Gemm g{xb, (const bf16*)(ws + WS_W_UP0), M, FF, D}; pg8::StaticOrder S; S.init(M, FF, F.G, (int)blockIdx.x);
        rstab_fill(F, S, stats);
        pg8::EpiUp E{r2, (const LAS float*)(F.lds + RSTAB_OFF)};
        pg8::gemm_phase<pg8::EpiUp, pg8::StaticOrder, PG8_ALIGN, PG8_SP2>(F.lds + RING_OFF, g, S, E);
        }
        if (BOTH(5)) GRID_BAR();
    }
    if (IN(6)) {
        REPS(6) {
        pg8::Gemm g{r2, (const bf16*)(ws + WS_W_DN0), M, D, FF}; pg8::StaticOrder S; S.init(M, D, F.G, (int)blockIdx.x);
        pg8::EpiRes E{xb, stats};
        pg8::gemm_phase<pg8::EpiRes, pg8::StaticOrder, PG8_ALIGN, PG8_SP2>(F.lds + RING_OFF, g, S, E);
        }
        if (BOTH(6)) GRID_BAR();
    }
    if (IN(7)) {
        stagger(STAG_TICKS);
        REPS(7) {
        pg8::Gemm g{xb, (const bf16*)(ws + WS_W_IN1), M, N_IN1, D}; pg8::StaticOrder S; S.init(M, N_IN1, F.G, (int)blockIdx.x);
        rstab_fill(F, S, stats);
        pg8::EpiIn1 E{(bf16*)(ws + WS_R2 + 64 * MiB), r2, (const LAS float*)(F.lds + RSTAB_OFF)};
        pg8::gemm_phase<pg8::EpiIn1, pg8::StaticOrder, PG8_ALIGN, PG8_SP2>(F.lds + RING_OFF, g, S, E);
        }
        if (BOTH(7)) GRID_BAR();
    }
    if (IN(8)) { REPS(8) { p8_shortconv(F, args); } if (BOTH(8)) GRID_BAR(); }
    if (IN(9)) {
        REPS(9) {
        pg8::Gemm g{(const bf16*)(ws + WS_R2 + 128 * MiB), (const bf16*)(ws + WS_W_OUT1), M, D, D}; pg8::StaticOrder S; S.init(M, D, F.G, (int)blockIdx.x);
        pg8::EpiRes E{xb, stats};
        pg8::gemm_phase<pg8::EpiRes, pg8::StaticOrder, PG8_ALIGN, PG8_SP2>(F.lds + RING_OFF, g, S, E);
        }
        if (BOTH(9)) GRID_BAR();
    }
    if (IN(10)) {
        stagger(STAG_TICKS);
        REPS(10) {
        pg8::Gemm g{xb, (const bf16*)(ws + WS_W_UP1), M, FF, D}; pg8::StaticOrder S; S.init(M, FF, F.G, (int)blockIdx.x);
        rstab_fill(F, S, stats);
        pg8::EpiUp E{r2, (const LAS float*)(F.lds + RSTAB_OFF)};
        pg8::gemm_phase<pg8::EpiUp, pg8::StaticOrder, PG8_ALIGN, PG8_SP2>(F.lds + RING_OFF, g, S, E);
        }
        if (BOTH(10)) GRID_BAR();
    }
    if (IN(11)) {
        REPS(11) {
        pg8::Gemm g{r2, (const bf16*)(ws + WS_W_DN1), M, D, FF}; pg8::StaticOrder S; S.init(M, D, F.G, (int)blockIdx.x);
#if FUSE_FINAL
        pg8::EpiFinal E{xb, args.out, args.in[16], stats, (unsigned*)(F.ctl + CW_SEAM), (unsigned*)(F.ctl + CW_TMO), F.lds + RING_BYTES};
        pg8::gemm_phase<pg8::EpiFinal, pg8::StaticOrder, true, PG8_SP2>(F.lds + RING_OFF, g, S, E);
#else
        pg8::EpiRes E{xb, stats};
        pg8::gemm_phase<pg8::EpiRes, pg8::StaticOrder, PG8_ALIGN, PG8_SP2>(F.lds + RING_OFF, g, S, E);
#endif
        }
        if (BOTH(11)) GRID_BAR();
    }
#if !FUSE_FINAL
    if (IN(12)) { p12_final_norm(F, args); }
#endif
#undef IN
#undef BOTH
}

extern "C" void kernel_launch(void* const* d_in, const int* in_sizes, int n_in, void* d_out, int out_size, void* d_ws, size_t ws_size, hipStream_t stream) {
    static int grid = 0;
    if (grid == 0) {
        if (n_in != 17 || in_sizes[0] != M * D || out_size != M * D || ws_size < WS_END) { fprintf(stderr, "kernel_launch: shape/workspace mismatch (n_in %d in0 %d out %d ws %zu, need %zu)\n", n_in, n_in > 0 ? in_sizes[0] : -1, out_size, ws_size, (size_t)WS_END); grid = -1; return; }
        int dev = 0, cus = 0, per_cu = 0;
        if (hipGetDevice(&dev) != hipSuccess || hipDeviceGetAttribute(&cus, hipDeviceAttributeMultiprocessorCount, dev) != hipSuccess) { grid = -1; return; }
        if (hipFuncSetAttribute((const void*)hybrid_fwd, hipFuncAttributeMaxDynamicSharedMemorySize, LDS_BYTES) != hipSuccess) { fprintf(stderr, "kernel_launch: hipFuncSetAttribute failed\n"); grid = -1; return; }
        if (hipOccupancyMaxActiveBlocksPerMultiprocessor(&per_cu, (const void*)hybrid_fwd, NWAVES * 64, LDS_BYTES) != hipSuccess || per_cu < 1) { fprintf(stderr, "kernel_launch: occupancy query says %d workgroups per CU\n", per_cu); }
        (void)hipGetLastError();
        grid = cus;
    }
    if (grid < 0) return;
    if (hipMemsetAsync((char*)d_ws + WS_CTL, 0, CTL_ZERO_BYTES, stream) != hipSuccess) return;
    Args a{};
    for (int i = 0; i < 17; ++i) a.in[i] = (const float*)d_in[i];
    a.out = (float*)d_out; a.ws = (unsigned char*)d_ws;
    for (int li = 0; li < N_LAUNCHES; ++li) {
        a.ph_lo = (N_LAUNCHES == 1) ? 0 : li; a.ph_hi = (N_LAUNCHES == 1) ? N_PHASES : li + 1; a.li = li;
        hipLaunchKernelGGL(hybrid_fwd, dim3(grid), dim3(NWAVES * 64), LDS_BYTES, stream, a);
    }
}
```

```cpp
#include <hip/hip_runtime.h>
#include <cstdio>
#include <cstdint>
namespace pg8 {
#define PG8_LAS __attribute__((address_space(3)))
typedef unsigned short bf16_t;
typedef short bf16x8 __attribute__((ext_vector_type(8)));
typedef float f32x4 __attribute__((ext_vector_type(4)));
typedef unsigned u32x4 __attribute__((ext_vector_type(4)));
constexpr int BM = 256, BK = 64, HALF = 128, HTB = HALF * BK * 2  , STAGE_BYTES = 8 * HTB, NXCD = 8, WGM = 8;

__host__ __device__ __forceinline__ int lds_byte(int r, int c) { const int st = (r >> 4) * 2 + (c >> 5), rr = r & 15, cc = c & 31, ob = rr * 64 + cc * 2; return st * 1024 + (ob ^ (((ob >> 9) & 1) << 5)); }
__host__ __device__ __forceinline__ void stage_rc(int b, int& R, int& C) { const int st = b / 1024, sb = b % 1024, swz = sb ^ (((sb >> 9) & 1) << 5); R = (st >> 1) * 16 + swz / 64; C = (st & 1) * 32 + (swz % 64) / 2; }
__host__ __device__ __forceinline__ int perm32(int rho) { const int n = rho >> 4, i = rho & 15; return 8 * (i >> 2) + 4 * n + (i & 3); }

struct Unit { int pm, pn, idx; };
struct Gemm { const bf16_t* A; const bf16_t* Bt; int M, N, K; };

struct StaticOrder {
    int nM, nN, nwg, G, c;
    __host__ __device__ void init(int M, int N, int G_, int c_) { nM = M / BM; nN = N / BM; nwg = nM * nN; G = G_; c = c_; }
    __host__ __device__ bool next(int i, Unit& u) const {
        const long L = (long)i * G + c; if (L >= nwg) return false;
        int wgid = (int)L; { const int q = nwg / NXCD, r = nwg % NXCD, xcd = wgid % NXCD, off = wgid / NXCD; wgid = (xcd < r ? xcd * (q + 1) : r * (q + 1) + (xcd - r) * q) + off; }
        const int nig = WGM * nN, gid = wgid / nig, fm = gid * WGM, gsz = (nM - fm) < WGM ? (nM - fm) : WGM;
        u.pm = fm + ((wgid % nig) % gsz); u.pn = (wgid % nig) / gsz; u.idx = i; return true;
    }
    __device__ __forceinline__ void a_ready(const Unit&) const {}
    __device__ __forceinline__ void done(const Unit&) const {}
};
__device__ __forceinline__ unsigned cvt_pk_bf16(float lo, float hi) { unsigned r; asm volatile("v_cvt_pk_bf16_f32 %0, %1, %2" : "=v"(r) : "v"(lo), "v"(hi)); return r; }
typedef float f32x2 __attribute__((ext_vector_type(2)));
#if defined(PROBE_KREP)
constexpr float KSC = 1.0f / PROBE_KREP;
#else
constexpr float KSC = 1.0f;
#endif
__device__ __forceinline__ void row_rstd(const PG8_LAS float* rstab, const Unit& u, int wr, int fr, float (&rs)[2][4]) {
#pragma unroll
    for (int ai = 0; ai < 2; ++ai)
#pragma unroll
        for (int m = 0; m < 4; ++m) rs[ai][m] = rstab[u.idx * BM + ai * HALF + wr * 64 + m * 16 + fr];
}
__device__ __forceinline__ u32x4 pack8(const f32x4 a, const f32x4 b) { u32x4 w; w.x = cvt_pk_bf16(a[0], a[1]); w.y = cvt_pk_bf16(a[2], a[3]); w.z = cvt_pk_bf16(b[0], b[1]); w.w = cvt_pk_bf16(b[2], b[3]); return w; }
#ifndef EPI_ST_SC1
#define EPI_ST_SC1 0
#endif
__device__ __forceinline__ void st16(bf16_t* p, const u32x4 v) {
#if EPI_ST_SC1
    asm volatile("global_store_dwordx4 %0, %1, off sc1\n\ts_nop 1" :: "v"(p), "v"(v) : "memory");
#else
    *(u32x4*)p = v;
#endif
}
__device__ __forceinline__ void stage16(PG8_LAS unsigned char* stg, int fr, int fq, const u32x4 v0, const u32x4 v1, u32x4& r0, u32x4& r1) {
    const int lane = fr + 16 * fq, x = fr & 7;
    *(PG8_LAS u32x4*)(stg + fr * 128 + ((fq ^ x) << 4)) = v0; *(PG8_LAS u32x4*)(stg + fr * 128 + (((4 + fq) ^ x) << 4)) = v1;
    const int rr = lane >> 3, c = lane & 7;
    r0 = *(const PG8_LAS u32x4*)(stg + rr * 128 + ((c ^ rr) << 4)); r1 = *(const PG8_LAS u32x4*)(stg + (rr + 8) * 128 + ((c ^ rr) << 4));
}
__device__ __forceinline__ float sigmoidf_(float g) { return __builtin_amdgcn_rcpf(1.0f + __builtin_amdgcn_exp2f(-1.4426950408889634f * g)); }

struct EpiIn0 {
    static constexpr bool WCOLS64 = true, PERM = true, AFTER_DRAIN = false, IDEMP = false;
    bf16_t* hglu; bf16_t* qkv; const PG8_LAS float* rstab; float qscale; PG8_LAS unsigned char* stg0;
    __device__ __forceinline__ void operator()(const f32x4 (&acc)[2][2][4][2], const Unit& u, int wr, int wc, int fr, int fq) const {
        const int row0 = u.pm * BM + wr * 64 + fr;
        float rs[2][4]; row_rstd(rstab, u, wr, fr, rs);
        if (u.pn < 4) {
            const int col0 = u.pn * 128 + wc * 32 + 8 * fq;
#pragma unroll
            for (int ai = 0; ai < 2; ++ai)
#pragma unroll
                for (int m = 0; m < 4; ++m) {
                    const float r = rs[ai][m];
                    f32x4 v0 = acc[ai][0][m][0] * r, v1 = acc[ai][0][m][1] * r; const f32x4 g0 = acc[ai][1][m][0] * r, g1 = acc[ai][1][m][1] * r;
#pragma unroll
                    for (int j = 0; j < 4; ++j) { v0[j] *= sigmoidf_(g0[j]); v1[j] *= sigmoidf_(g1[j]); }
                    st16(hglu + (size_t)(row0 + ai * HALF + m * 16) * 512 + col0, pack8(v0, v1));
                }
        } else {
            const int colt = (u.pn - 4) * BM; const float sc = colt < 1536 ? qscale : 1.0f; const int g2 = 2 * ((colt >> 9) % 3), plane = (colt >> 6) + wc;
            PG8_LAS unsigned char* stg = stg0 + (wr * 4 + wc) * 2048; const int lane = fr + 16 * fq, rr = lane >> 3, c = lane & 7;
#pragma unroll
            for (int ai = 0; ai < 2; ++ai)
#pragma unroll
                for (int m = 0; m < 4; ++m) {
                    const float r = rs[ai][m] * sc; u32x4 o0, o1;
                    stage16(stg, fr, fq, pack8(acc[ai][0][m][0] * r, acc[ai][0][m][1] * r), pack8(acc[ai][1][m][0] * r, acc[ai][1][m][1] * r), o0, o1);
#pragma unroll
                    for (int k = 0; k < 2; ++k) { const int row = u.pm * BM + ai * HALF + wr * 64 + m * 16 + 8 * k + rr, b = row >> 13, p = row & 8191;
                        const int pp = ((p & ((1 << g2) - 1)) << (13 - g2)) + (p >> g2);
                        st16(qkv + ((size_t)((plane * 4 + b) * 8192 + pp) << 6) + 8 * c, k ? o1 : o0); }
                }
        }
    }
};
__device__ __forceinline__ float bflo_(unsigned w) { return __builtin_bit_cast(float, w << 16); }
__device__ __forceinline__ float bfhi_(unsigned w) { return __builtin_bit_cast(float, w & 0xffff0000u); }
struct EpiRes {
    static constexpr bool WCOLS64 = false, PERM = true, AFTER_DRAIN = false, IDEMP = false;
    bf16_t* xb; float* stats;
    __device__ __forceinline__ void operator()(const f32x4 (&acc)[2][2][4][2], const Unit& u, int wr, int wc, int fr, int fq) const {
        const int row0 = u.pm * BM + wr * 64 + fr, col0 = u.pn * BM + wc * 32 + 8 * fq;
#pragma unroll
        for (int ai = 0; ai < 2; ++ai)
#pragma unroll
            for (int m = 0; m < 4; ++m) {
                const int row = row0 + ai * HALF + m * 16; const size_t off = (size_t)row * 1024 + col0; float ss = 0.f;
#pragma unroll
                for (int bj = 0; bj < 2; ++bj) {
                    const u32x4 b = *(const u32x4*)(xb + off + bj * HALF);
                    const f32x4 o0 = (f32x4){bflo_(b.x), bfhi_(b.x), bflo_(b.y), bfhi_(b.y)} + acc[ai][bj][m][0] * KSC, o1 = (f32x4){bflo_(b.z), bfhi_(b.z), bflo_(b.w), bfhi_(b.w)} + acc[ai][bj][m][1] * KSC;
                    ss += (o0[0] * o0[0] + o0[1] * o0[1]) + (o0[2] * o0[2] + o0[3] * o0[3]) + (o1[0] * o1[0] + o1[1] * o1[1]) + (o1[2] * o1[2] + o1[3] * o1[3]);
                    st16(xb + off + bj * HALF, pack8(o0, o1));
                }
                ss += __shfl_xor(ss, 16); ss += __shfl_xor(ss, 32);
                if (fq == 0) stats[(size_t)row * 16 + u.pn * 4 + wc] = ss;
            }
    }
};
struct EpiFinal {
    static constexpr bool WCOLS64 = false, PERM = true, AFTER_DRAIN = false, IDEMP = false;
    const bf16_t* xb; float* out; const float* gain; float* xslot; unsigned* cnt; unsigned* tmo; PG8_LAS unsigned char* lx;
    __device__ __forceinline__ void operator()(f32x4 (&acc)[2][2][4][2], const Unit& u, int wr, int wc, int fr, int fq) const {
        const int tid = threadIdx.x, lane = tid & 63, wid = __builtin_amdgcn_readfirstlane(tid >> 6);
        PG8_LAS float* P = (PG8_LAS float*)lx; PG8_LAS float* S = (PG8_LAS float*)(lx + 4096); PG8_LAS unsigned* flag = (PG8_LAS unsigned*)(lx + 5120);
        const int rl0 = wr * 64 + fr, col0 = u.pn * BM + wc * 32 + 8 * fq;
#pragma unroll
        for (int ai = 0; ai < 2; ++ai)
#pragma unroll
            for (int m = 0; m < 4; ++m) {
                const int rl = rl0 + ai * HALF + m * 16; const size_t off = (size_t)(u.pm * BM + rl) * 1024 + col0; float ss = 0.f;
#pragma unroll
                for (int bj = 0; bj < 2; ++bj) {
                    const u32x4 b = *(const u32x4*)(xb + off + bj * HALF);
                    const f32x4 o0 = (f32x4){bflo_(b.x), bfhi_(b.x), bflo_(b.y), bfhi_(b.y)} + acc[ai][bj][m][0] * KSC, o1 = (f32x4){bflo_(b.z), bfhi_(b.z), bflo_(b.w), bfhi_(b.w)} + acc[ai][bj][m][1] * KSC;
                    ss += (o0[0] * o0[0] + o0[1] * o0[1]) + (o0[2] * o0[2] + o0[3] * o0[3]) + (o1[0] * o1[0] + o1[1] * o1[1]) + (o1[2] * o1[2] + o1[3] * o1[3]);
                    acc[ai][bj][m][0] = o0; acc[ai][bj][m][1] = o1;
                }
                ss += __shfl_xor(ss, 16); ss += __shfl_xor(ss, 32);
                if (fq == 0) P[rl * 4 + wc] = ss;
            }
        asm volatile("s_waitcnt lgkmcnt(0)" ::: "memory"); __builtin_amdgcn_s_barrier(); asm volatile("" ::: "memory");
        if (tid < 256) { const f32x4 p = *(const PG8_LAS f32x4*)(P + tid * 4);
            __hip_atomic_store(xslot + (size_t)(u.pm * BM + tid) * 4 + u.pn, (p[0] + p[1]) + (p[2] + p[3]), __ATOMIC_RELAXED, __HIP_MEMORY_SCOPE_AGENT); }
        asm volatile("s_waitcnt vmcnt(0)" ::: "memory");
        if (tid < 256 && lane == 0) __hip_atomic_fetch_add(cnt + 64 * u.pm, 1u, __ATOMIC_RELAXED, __HIP_MEMORY_SCOPE_AGENT);
        if (wid == 0) {
            bool dead = false; const unsigned long long t0 = __builtin_amdgcn_s_memrealtime();
            for (;;) {
                if ((unsigned)__builtin_amdgcn_readfirstlane(__hip_atomic_load(cnt + 64 * u.pm, __ATOMIC_RELAXED, __HIP_MEMORY_SCOPE_AGENT)) >= 16u) break;
                if (__builtin_amdgcn_s_memrealtime() - t0 > 2000000ull) { if (lane == 0) __hip_atomic_store(tmo, 1u, __ATOMIC_RELAXED, __HIP_MEMORY_SCOPE_AGENT); dead = true; break; }
                __builtin_amdgcn_s_sleep(2);
            }
            __builtin_amdgcn_fence(__ATOMIC_ACQUIRE, "agent");
            if (lane == 0) flag[0] = dead ? 1u : 0u;
        }
        asm volatile("s_waitcnt vmcnt(0) lgkmcnt(0)" ::: "memory"); __builtin_amdgcn_s_barrier(); asm volatile("" ::: "memory");
        if (tid < 256) { const float* sl = xslot + (size_t)(u.pm * BM + tid) * 4; float q = 0.f;
#pragma unroll
            for (int t = 0; t < 4; ++t) q += __hip_atomic_load(sl + t, __ATOMIC_RELAXED, __HIP_MEMORY_SCOPE_AGENT);
            S[tid] = __builtin_amdgcn_rsqf(q * (1.0f / 1024.0f) + 1e-6f); }
        asm volatile("s_waitcnt lgkmcnt(0)" ::: "memory"); __builtin_amdgcn_s_barrier(); asm volatile("" ::: "memory");
        f32x4 gv[2][2];
#pragma unroll
        for (int bj = 0; bj < 2; ++bj) { gv[bj][0] = *(const f32x4*)(gain + col0 + bj * HALF); gv[bj][1] = *(const f32x4*)(gain + col0 + bj * HALF + 4); }
#pragma unroll
        for (int ai = 0; ai < 2; ++ai)
#pragma unroll
            for (int m = 0; m < 4; ++m) {
                const int rl = rl0 + ai * HALF + m * 16; const float rstd = S[rl]; float* op = out + (size_t)(u.pm * BM + rl) * 1024 + col0;
#pragma unroll
                for (int bj = 0; bj < 2; ++bj) { *(f32x4*)(op + bj * HALF) = acc[ai][bj][m][0] * rstd * gv[bj][0]; *(f32x4*)(op + bj * HALF + 4) = acc[ai][bj][m][1] * rstd * gv[bj][1]; }
            }
    }
};
struct EpiUp {
    static constexpr bool WCOLS64 = true, PERM = true, AFTER_DRAIN = false, IDEMP = false;
    bf16_t* z; const PG8_LAS float* rstab; PG8_LAS unsigned char* stg0;
    __device__ __forceinline__ void operator()(const f32x4 (&acc)[2][2][4][2], const Unit& u, int wr, int wc, int fr, int fq) const {
        float rs[2][4]; row_rstd(rstab, u, wr, fr, rs);
        PG8_LAS unsigned char* stg = stg0 + (wr * 4 + wc) * 2048; const int lane = fr + 16 * fq, rr = lane >> 3, c = lane & 7;
        bf16_t* zb = z + (size_t)(u.pm * BM + wr * 64 + rr) * 4096 + u.pn * BM + wc * 64 + 8 * c;
#pragma unroll
        for (int ai = 0; ai < 2; ++ai)
#pragma unroll
            for (int m = 0; m < 4; ++m) {
                const float r = rs[ai][m]; u32x4 pk[2];
#pragma unroll
                for (int bj = 0; bj < 2; ++bj) {
                    f32x4 a = acc[ai][bj][m][0] * r, b = acc[ai][bj][m][1] * r;
#pragma unroll
                    for (int j = 0; j < 4; ++j) { const float x = fmaxf(a[j], 0.f), y = fmaxf(b[j], 0.f); a[j] = x * x; b[j] = y * y; }
                    pk[bj] = pack8(a, b);
                }
                u32x4 o0, o1; stage16(stg, fr, fq, pk[0], pk[1], o0, o1);
                st16(zb + (size_t)(ai * HALF + m * 16) * 4096, o0); st16(zb + (size_t)(ai * HALF + m * 16 + 8) * 4096, o1);
            }
    }
};
struct EpiIn1 {
    static constexpr bool WCOLS64 = true, PERM = true, AFTER_DRAIN = false, IDEMP = false;
    bf16_t* cv; bf16_t* bg; const PG8_LAS float* rstab; PG8_LAS unsigned char* stg0;
    __device__ __forceinline__ void operator()(const f32x4 (&acc)[2][2][4][2], const Unit& u, int wr, int wc, int fr, int fq) const {
        const int row0 = u.pm * BM + wr * 64 + fr;
        float rs[2][4]; row_rstd(rstab, u, wr, fr, rs);
        if (u.pn < 8) {
            const int col0 = u.pn * 128 + wc * 32 + 8 * fq;
#pragma unroll
            for (int ai = 0; ai < 2; ++ai)
#pragma unroll
                for (int m = 0; m < 4; ++m) {
                    const float r2 = rs[ai][m] * rs[ai][m];
                    st16(cv + (size_t)(row0 + ai * HALF + m * 16) * 1024 + col0, pack8(acc[ai][0][m][0] * acc[ai][1][m][0] * r2, acc[ai][0][m][1] * acc[ai][1][m][1] * r2));
                }
        } else {
            PG8_LAS unsigned char* stg = stg0 + (wr * 4 + wc) * 2048; const int lane = fr + 16 * fq, rr = lane >> 3, c = lane & 7;
            bf16_t* bb = bg + (size_t)(u.pm * BM + wr * 64 + rr) * 1024 + (u.pn - 8) * BM + wc * 64 + 8 * c;
#pragma unroll
            for (int ai = 0; ai < 2; ++ai)
#pragma unroll
                for (int m = 0; m < 4; ++m) {
                    const float r = rs[ai][m]; u32x4 o0, o1;
                    stage16(stg, fr, fq, pack8(acc[ai][0][m][0] * r, acc[ai][0][m][1] * r), pack8(acc[ai][1][m][0] * r, acc[ai][1][m][1] * r), o0, o1);
                    st16(bb + (size_t)(ai * HALF + m * 16) * 1024, o0); st16(bb + (size_t)(ai * HALF + m * 16 + 8) * 1024, o1);
                }
        }
    }
};
template <class Epi, class Sched, bool ALIGN_EPI = false, bool SP2 = false>
__device__ __forceinline__ void gemm_phase(PG8_LAS unsigned char* lds, const Gemm g, const Sched& S, const Epi& E) {
    const int tid = threadIdx.x, wid = __builtin_amdgcn_readfirstlane(tid >> 6), lane = tid & 63, wr = wid >> 2, wc = wid & 3, fr = lane & 15, fq = lane >> 4;
    const int K = g.K, nt = K / BK;
    unsigned voffA[2], voffB[2];
#pragma unroll
    for (int i = 0; i < 2; ++i) { int R, C; stage_rc(tid * 16 + i * 8192, R, C); const int r31_ = Epi::PERM ? perm32(R & 31) : (R & 31); const int Rb = (Epi::WCOLS64 ? 64 : 32) * (R >> 5) + r31_;
        voffA[i] = (unsigned)(R * K + C) * 2u; voffB[i] = (unsigned)(Rb * K + C) * 2u; }
    const size_t kstep = (size_t)(BK * 2);
    const size_t hstep = (size_t)HALF * K * 2;
    const size_t tstep = 2 * hstep;
    const size_t hstepB = Epi::WCOLS64 ? (size_t)32 * K * 2 : hstep;
    const unsigned ldsw = (unsigned)wid * 1024u;
    const int aoff = lds_byte(wr * 64 + fr, fq * 8), boff = lds_byte(wc * 32 + fr, fq * 8);
#define PG8_SA(b, h) (((b) * 2 + (h)) * HTB)
#define PG8_SB(b, h) ((4 + (b) * 2 + (h)) * HTB)
#define PG8_STAGE(bufoff, gbase, voff) do { _Pragma("unroll") for (int _i = 0; _i < 2; ++_i) \
        __builtin_amdgcn_global_load_lds((const unsigned*)((const char*)(gbase) + (voff)[_i]), (PG8_LAS unsigned*)(lds + (bufoff) + ldsw + _i * 8192), 16, 0, 0); } while (0)
#define PG8_LDA(dst, b, h) do { _Pragma("unroll") for (int m = 0; m < 4; ++m) _Pragma("unroll") for (int k = 0; k < 2; ++k) dst[m][k] = *(const PG8_LAS bf16x8*)(lds + PG8_SA(b, h) + aoff + m * 2048 + k * 1024); } while (0)
#define PG8_LDB(dst, b, h) do { _Pragma("unroll") for (int n = 0; n < 2; ++n) _Pragma("unroll") for (int k = 0; k < 2; ++k) dst[n][k] = *(const PG8_LAS bf16x8*)(lds + PG8_SB(b, h) + boff + n * 2048 + k * 1024); } while (0)
#if defined(PROBE_MMA2)
#define PG8_MMA_AGAIN(ai, bj, At, Bt) _Pragma("unroll") for (int m = 0; m < 4; ++m) _Pragma("unroll") for (int n = 0; n < 2; ++n) _Pragma("unroll") for (int k = 0; k < 2; ++k) \
        acc[ai][bj][m][n] = __builtin_amdgcn_mfma_f32_16x16x32_bf16(Bt[n][k], At[m][k], acc[ai][bj][m][n], 0, 0, 0);
#else
#define PG8_MMA_AGAIN(ai, bj, At, Bt)
#endif
#define PG8_MMA(ai, bj, At, Bt) do { __builtin_amdgcn_s_setprio(1); _Pragma("unroll") for (int m = 0; m < 4; ++m) _Pragma("unroll") for (int n = 0; n < 2; ++n) _Pragma("unroll") for (int k = 0; k < 2; ++k) \
        acc[ai][bj][m][n] = __builtin_amdgcn_mfma_f32_16x16x32_bf16(Bt[n][k], At[m][k], acc[ai][bj][m][n], 0, 0, 0); PG8_MMA_AGAIN(ai, bj, At, Bt) __builtin_amdgcn_s_setprio(0); } while (0)
#define PG8_WAIT_V(n) asm volatile("s_waitcnt vmcnt(" #n ")" ::: "memory")
#define PG8_WAIT_L(n) asm volatile("s_waitcnt lgkmcnt(" #n ")" ::: "memory")
#define PG8_BAR __builtin_amdgcn_s_barrier()
#define PG8_SCHED __builtin_amdgcn_sched_barrier(0)
    Unit cur, nxt; int ui = 0;
    if (!S.next(0, cur)) return;
    f32x4 acc[2][2][4][2];
#pragma unroll
    for (int a = 0; a < 2; ++a)
#pragma unroll
        for (int b = 0; b < 2; ++b)
#pragma unroll
            for (int m = 0; m < 4; ++m)
#pragma unroll
                for (int n = 0; n < 2; ++n) acc[a][b][m][n] = (f32x4){0.f, 0.f, 0.f, 0.f};
    bf16x8 At[4][2], B0[2][2], B1[2][2];
    const char* cA = (const char*)g.A + (size_t)cur.pm * tstep; const char* cB = (const char*)g.Bt + (size_t)cur.pn * tstep;
    S.a_ready(cur);
    if constexpr (SP2) {
        PG8_STAGE(PG8_SB(0, 0), cB, voffB); PG8_STAGE(PG8_SB(0, 1), cB + hstepB, voffB); PG8_STAGE(PG8_SA(0, 0), cA, voffA); PG8_STAGE(PG8_SA(0, 1), cA + hstep, voffA);
        if (wr == 1) PG8_BAR;
        PG8_WAIT_V(2); PG8_BAR;
        PG8_STAGE(PG8_SB(1, 0), cB + kstep, voffB); PG8_STAGE(PG8_SA(1, 0), cA + kstep, voffA); PG8_STAGE(PG8_SB(1, 1), cB + hstepB + kstep, voffB);
        PG8_WAIT_V(6); PG8_BAR;
    } else {
        PG8_STAGE(PG8_SB(0, 0), cB, voffB); PG8_STAGE(PG8_SA(0, 0), cA, voffA); PG8_STAGE(PG8_SB(0, 1), cB + hstepB, voffB); PG8_STAGE(PG8_SA(0, 1), cA + hstep, voffA);
        if (wr == 1) PG8_BAR;
        PG8_WAIT_V(4); PG8_BAR;
        PG8_STAGE(PG8_SB(1, 0), cB + kstep, voffB); PG8_STAGE(PG8_SA(1, 0), cA + kstep, voffA); PG8_STAGE(PG8_SB(1, 1), cB + hstepB + kstep, voffB);
        PG8_WAIT_V(6); PG8_BAR;
    }
    for (;;) {
        const bool has_next = S.next(ui + 1, nxt);
        const char* nA = has_next ? (const char*)g.A + (size_t)nxt.pm * tstep : cA; const char* nB = has_next ? (const char*)g.Bt + (size_t)nxt.pn * tstep : cB;
#if !defined(PROBE_KREP)
#define PROBE_KREP 1
#endif
#if defined(PROBE_MMA2)
#define PROBE_KLOOP_REP 1
#else
#define PROBE_KLOOP_REP PROBE_KREP
#endif
        for (int tt_ = 0; tt_ < nt * PROBE_KLOOP_REP; tt_ += 2) {
            const int t = tt_ & (nt - 1), t2 = (tt_ + 2) & (nt - 1);
            const bool last = (tt_ == nt * PROBE_KLOOP_REP - 2);
            const char* a1 = cA + (size_t)(t + 1) * kstep;
            const char* a2 = last ? nA : cA + (size_t)t2 * kstep; const char* b2 = last ? nB : cB + (size_t)t2 * kstep;
            const char* a3 = a2 + kstep; const char* b3 = b2 + kstep;
            if (last && has_next) S.a_ready(nxt);
            if constexpr (SP2) {
            PG8_LDB(B0, 0, 0); PG8_LDB(B1, 0, 1); PG8_SCHED; PG8_LDA(At, 0, 0); PG8_STAGE(PG8_SA(1, 1), a1 + hstep, voffA);
            PG8_WAIT_V(8); PG8_WAIT_L(0); PG8_BAR; PG8_MMA(0, 0, At, B0); PG8_MMA(0, 1, At, B1); PG8_BAR; PG8_SCHED;
            PG8_LDA(At, 0, 1); PG8_STAGE(PG8_SB(0, 0), b2, voffB); PG8_STAGE(PG8_SB(0, 1), b2 + hstepB, voffB); PG8_STAGE(PG8_SA(0, 0), a2, voffA);
            PG8_WAIT_V(8); PG8_WAIT_L(0); PG8_BAR; PG8_MMA(1, 0, At, B0); PG8_MMA(1, 1, At, B1); PG8_BAR; PG8_SCHED;
            PG8_LDB(B0, 1, 0); PG8_LDB(B1, 1, 1); PG8_SCHED; PG8_LDA(At, 1, 0); PG8_STAGE(PG8_SA(0, 1), a2 + hstep, voffA);
            PG8_WAIT_V(8); PG8_WAIT_L(0); PG8_BAR; PG8_MMA(0, 0, At, B0); PG8_MMA(0, 1, At, B1); PG8_BAR; PG8_SCHED;
            PG8_LDA(At, 1, 1); PG8_STAGE(PG8_SB(1, 0), b3, voffB); PG8_STAGE(PG8_SB(1, 1), b3 + hstepB, voffB); PG8_STAGE(PG8_SA(1, 0), a3, voffA);
            PG8_WAIT_V(8); PG8_WAIT_L(0); PG8_BAR; PG8_MMA(1, 0, At, B0); PG8_MMA(1, 1, At, B1); PG8_BAR; PG8_SCHED;
            } else {
            PG8_LDB(B0, 0, 0); PG8_SCHED; PG8_LDA(At, 0, 0); PG8_STAGE(PG8_SA(1, 1), a1 + hstep, voffA);
            PG8_WAIT_L(8); PG8_BAR; PG8_WAIT_L(0); PG8_MMA(0, 0, At, B0); PG8_BAR; PG8_SCHED;
            PG8_LDB(B1, 0, 1); PG8_STAGE(PG8_SB(0, 0), b2, voffB);
            PG8_BAR; PG8_WAIT_L(0); PG8_MMA(0, 1, At, B1); PG8_BAR;
            PG8_LDA(At, 0, 1); PG8_STAGE(PG8_SA(0, 0), a2, voffA);
            PG8_BAR; PG8_WAIT_L(0); PG8_MMA(1, 0, At, B0); PG8_BAR; PG8_SCHED;
            PG8_STAGE(PG8_SB(0, 1), b2 + hstepB, voffB);
            PG8_WAIT_V(6); PG8_BAR; PG8_MMA(1, 1, At, B1); PG8_BAR;
            PG8_LDB(B0, 1, 0); PG8_SCHED; PG8_LDA(At, 1, 0); PG8_STAGE(PG8_SA(0, 1), a2 + hstep, voffA);
            PG8_WAIT_L(8); PG8_BAR; PG8_WAIT_L(0); PG8_MMA(0, 0, At, B0); PG8_BAR; PG8_SCHED;
            PG8_LDB(B1, 1, 1); PG8_STAGE(PG8_SB(1, 0), b3, voffB);
            PG8_BAR; PG8_WAIT_L(0); PG8_MMA(0, 1, At, B1); PG8_BAR;
            PG8_LDA(At, 1, 1); PG8_STAGE(PG8_SA(1, 0), a3, voffA);
            PG8_BAR; PG8_WAIT_L(0); PG8_MMA(1, 0, At, B0); PG8_BAR; PG8_SCHED;
            PG8_STAGE(PG8_SB(1, 1), b3 + hstepB, voffB);
            PG8_WAIT_V(6); PG8_BAR; PG8_MMA(1, 1, At, B1); PG8_BAR;
            }
        }
        if constexpr (ALIGN_EPI) { if (wr == 0) PG8_BAR; }
        if constexpr (!Epi::AFTER_DRAIN) { E(acc, cur, wr, wc, fr, fq);
#if defined(PROBE_EPI2)
            if constexpr (Epi::IDEMP) { asm volatile("" ::: "memory"); E.probe(acc, cur, wr, wc, fr, fq); }
#endif
            S.done(cur); }
        if (!has_next) break;
#pragma unroll
        for (int a = 0; a < 2; ++a)
#pragma unroll
            for (int b = 0; b < 2; ++b)
#pragma unroll
                for (int m = 0; m < 4; ++m)
#pragma unroll
                    for (int n = 0; n < 2; ++n) acc[a][b][m][n] = (f32x4){0.f, 0.f, 0.f, 0.f};
        cur = nxt; cA = nA; cB = nB; ++ui;
        if constexpr (ALIGN_EPI) { if (wr == 1) PG8_BAR; }
    }
    PG8_WAIT_V(0);
    if constexpr (!ALIGN_EPI) { if (wr == 0) PG8_BAR; }
    PG8_BAR;
    if constexpr (Epi::AFTER_DRAIN) { E.fused(acc, cur, wr, wc, fr, fq, lds, wid, lane); S.done(cur); }
#undef PG8_SA
#undef PG8_SB
#undef PG8_STAGE
#undef PG8_LDA
#undef PG8_LDB
#undef PG8_MMA
#undef PG8_WAIT_V
#undef PG8_WAIT_L
#undef PG8_BAR
#undef PG8_SCHED
}
}
#ifndef PG8_SP2
#define PG8_SP2 true
#endif
#ifndef PG8_ALIGN
#define PG8_ALIGN true
#endif
constexpr int CW_BAR = 4096;
constexpr int CW_TMO = 0, CW_SEAM = 16384;
#define GAS __attribute__((address_space(1)))
#define LAS __attribute__((address_space(3)))
typedef unsigned short bf16;
typedef unsigned v4u __attribute__((ext_vector_type(4)));
typedef float f32x4 __attribute__((ext_vector_type(4)));
typedef short bf16x8 __attribute__((ext_vector_type(8)));
typedef GAS unsigned gu32;
typedef GAS unsigned long long gu64;
#define RLX_AGENT __ATOMIC_RELAXED, __HIP_MEMORY_SCOPE_AGENT
#define LDS_WAIT() asm volatile("s_waitcnt lgkmcnt(0)" ::: "memory")
#define VM_WAIT() asm volatile("s_waitcnt vmcnt(0)" ::: "memory")
__device__ __forceinline__ unsigned long long rt() { return __builtin_amdgcn_s_memrealtime(); }
__device__ __forceinline__ unsigned f2bf(float f) { unsigned u = __builtin_bit_cast(unsigned, f); return (u + 0x7fffu + ((u >> 16) & 1u)) >> 16; }
__device__ __forceinline__ unsigned pk2(float lo, float hi) { return f2bf(lo) | (f2bf(hi) << 16); }

#define XB_TMO      128
#define XB_XCNT(j)  (256  + 64 * (j))
#define XB_XSUB(j)  (1280 + 64 * (j))
#define XB_XGEN(j)  (2304 + 64 * (j))
#define XB_TOP      3328
#define XB_TOPGEN   3392
#define XCD_BAR_WORDS 3456
#define XB_SPIN_CAP (1u << 18)

__device__ __forceinline__ unsigned xb_ld(unsigned* p)              { return __hip_atomic_load(p, __ATOMIC_RELAXED, __HIP_MEMORY_SCOPE_AGENT); }
__device__ __forceinline__ unsigned xb_add(unsigned* p, unsigned v) { return __hip_atomic_fetch_add(p, v, __ATOMIC_RELAXED, __HIP_MEMORY_SCOPE_AGENT); }
__device__ __forceinline__ unsigned xb_xcc_id() { return (unsigned)__builtin_amdgcn_s_getreg((3 << 11) | 20) & 0xFu; }
#define XB_SPIN(cond, bar) do { unsigned _sp = 0; while (cond) { __builtin_amdgcn_s_sleep(1); \
    if ((++_sp & 255u) == 0u) { if (xb_ld(&(bar)[XB_TMO])) break; if (_sp > XB_SPIN_CAP) { atomicAdd(&(bar)[XB_TMO], 1u); break; } } } } while (0)

struct XcdBarrier {
    unsigned* bar; unsigned x;
    volatile LAS unsigned* st;
};

__device__ __forceinline__ XcdBarrier xcd_barrier_post(unsigned* bar, volatile LAS unsigned* st) {
    XcdBarrier b; b.bar = bar; b.x = xb_xcc_id(); b.st = st;
    if (threadIdx.x == 0) (void)xb_add(&bar[XB_XCNT(b.x)], 1u);
    return b;
}
__device__ __forceinline__ void xcd_barrier_complete(unsigned* bar, unsigned x, unsigned& nloc, unsigned& nx) {
    const unsigned G = gridDim.x * gridDim.y * gridDim.z;
    unsigned sum, cnt, mine, sp = 0u;
    for (;;) {
        sum = 0u; cnt = 0u; mine = 0u;
#pragma unroll
        for (unsigned j = 0; j < 16; ++j) { const unsigned c = xb_ld(&bar[XB_XCNT(j)]); sum += c; cnt += (c > 0u) ? 1u : 0u; mine = (j == x) ? c : mine; }
        if (sum == G) break;
        __builtin_amdgcn_s_sleep(1);
        if ((++sp & 255u) == 0u) { if (xb_ld(&bar[XB_TMO])) break; if (sp > XB_SPIN_CAP) { atomicAdd(&bar[XB_TMO], 1u); break; } }
    }
    nloc = mine > 0u ? mine : 1u; nx = cnt > 0u ? cnt : 1u;
}

__device__ __forceinline__ void xcd_barrier(const XcdBarrier& b) {
    asm volatile("s_waitcnt vmcnt(0)" ::: "memory");
    __syncthreads();
    if (threadIdx.x == 0) {
        unsigned* bar = b.bar;
        __builtin_amdgcn_s_waitcnt(0);
        unsigned nloc = b.st[0], nx = b.st[1];
        if (nloc == 0u) { xcd_barrier_complete(bar, b.x, nloc, nx); b.st[0] = nloc; b.st[1] = nx; }
        const unsigned old = xb_add(&bar[XB_XSUB(b.x)], 1u);
        const unsigned gen = old / nloc;
        if (old + 1u == (gen + 1u) * nloc) {
            __builtin_amdgcn_fence(__ATOMIC_RELEASE, "agent");
            asm volatile("s_waitcnt vmcnt(0)" ::: "memory");
            const unsigned og = xb_add(&bar[XB_TOP], 1u);
            const unsigned tg = og / nx;
            if (og + 1u == (tg + 1u) * nx) xb_add(&bar[XB_TOPGEN], 1u);
            else XB_SPIN(xb_ld(&bar[XB_TOPGEN]) == tg, bar);
            __builtin_amdgcn_fence(__ATOMIC_ACQUIRE, "agent");
            xb_add(&bar[XB_XGEN(b.x)], 1u);
            asm volatile("s_waitcnt vmcnt(0)" ::: "memory");
        } else {
            XB_SPIN(xb_ld(&bar[XB_XGEN(b.x)]) == gen, bar);
            __builtin_amdgcn_fence(__ATOMIC_ACQUIRE, "agent");
            asm volatile("s_waitcnt vmcnt(0)" ::: "memory");
        }
    }
    __syncthreads();
}

constexpr int NWAVES = 8;
#ifndef MK_N_LAUNCHES
#define MK_N_LAUNCHES 1
#endif
#ifndef FUSE_FINAL
#define FUSE_FINAL 0
#endif
constexpr int N_PHASES = FUSE_FINAL ? 12 : 13;
#ifndef PROBE_MASK
#define PROBE_MASK 0
#endif
#define REPS(k) for (int rep_ = 0; rep_ < (((PROBE_MASK) >> (k)) & 1) + 1; ++rep_)
constexpr int N_LAUNCHES = MK_N_LAUNCHES;

constexpr int BATCH = 4, SEQ = 8192, D = 1024, M = BATCH * SEQ, FF = 4096, N_IN0 = 5632, N_IN1 = 3072, NQKV = 4608, CA = 512, CONVW = 31;
constexpr float LOG2E = 1.4426950408889634f, QSCALE = 0.125f * LOG2E, RMS_EPS = 1e-6f, LN_EPS = 1e-5f;

constexpr size_t MiB = 1u << 20;
constexpr size_t WS_CTL = 0, CTL_ZERO_BYTES = 1 * MiB;
constexpr size_t WS_STATS = 1 * MiB;
constexpr size_t WS_BIAS2 = 3 * MiB;
constexpr size_t WS_LSE = 4 * MiB;
constexpr size_t WS_W_IN0 = 8 * MiB, WS_W_OUT0 = 19 * MiB, WS_W_UP0 = 21 * MiB, WS_W_DN0 = 29 * MiB, WS_W_IN1 = 37 * MiB, WS_W_OUT1 = 43 * MiB, WS_W_UP1 = 45 * MiB, WS_W_DN1 = 53 * MiB;
constexpr size_t WS_XB = 64 * MiB;
constexpr size_t WS_R2 = 128 * MiB;
constexpr size_t WS_END = 416 * MiB;
constexpr size_t OUT_OG = 0, OUT_HGLU = 96 * MiB;

constexpr int RING_OFF = 0, RING_BYTES = 131072;
constexpr int AT_K = 0, AT_V = 49152, AT_BT = 98304, AT_WS = 118784, AT_OST = 120832, AT_END = 153600;
constexpr int RSTAB_OFF = RING_BYTES, ESTG_OFF = RING_BYTES + 11264;
constexpr int LDSCTL_OFF = 162816, MISC_OFF = LDSCTL_OFF + 320;
constexpr int LDS_BYTES = 163840;
static_assert(ESTG_OFF + 16384 <= LDSCTL_OFF && AT_END <= LDSCTL_OFF, "LDS map");

struct Frame {
    LAS unsigned char* lds;
    volatile LAS unsigned* MISC;
    gu32* ctl;
    int tid, lane, wave;
    int vcu, G;
};
struct Args { const float* in[17]; float* out; unsigned char* ws; int ph_lo, ph_hi, li, pad; };

__device__ __forceinline__ float wave_sum(float v) {
#pragma unroll
    for (int o = 1; o < 64; o <<= 1) v += __shfl_xor(v, o);
    return v;
}
__device__ __forceinline__ float bf2f(unsigned short b) { return __builtin_bit_cast(float, (unsigned)b << 16); }
__device__ __forceinline__ float bflo(unsigned w) { return __builtin_bit_cast(float, w << 16); }
__device__ __forceinline__ float bfhi(unsigned w) { return __builtin_bit_cast(float, w & 0xffff0000u); }

__device__ __forceinline__ int colmap(int mode, int n0) {
    if (mode == 1) { if (n0 < 512) return 256 * (n0 >> 7) + 64 * ((n0 & 127) >> 5) + (n0 & 31); if (n0 < 1024) { const int c = n0 - 512; return 256 * (c >> 7) + 64 * ((c & 127) >> 5) + 32 + (c & 31); } return n0; }
    if (mode == 2) { if (n0 < 1024) return 2048 + n0; if (n0 < 2048) { const int c = n0 - 1024; return 256 * (c >> 7) + 64 * ((c & 127) >> 5) + (c & 31); } const int v = n0 - 2048; return 256 * (v >> 7) + 64 * ((v & 127) >> 5) + 32 + (v & 31); }
    return n0;
}
__device__ __forceinline__ void p0_transpose_item(const float* W, int K, int N, bf16* WT, const float* gain, int mode, LAS float* scr, int item, int lane) {
    const int nblk = N / 64, kb = item / nblk, nb = item % nblk, k0 = 64 * kb, n0 = 64 * nb;
    const int lk = lane >> 4, n4 = 4 * (lane & 15);
#pragma unroll 4
    for (int i = 0; i < 16; ++i) { const int kk = 4 * i + lk; const float g = gain ? gain[k0 + kk] : 1.0f; const f32x4 v = *(const GAS f32x4*)(W + (size_t)(k0 + kk) * N + n0 + n4);
        LAS float* d = scr + kk * 65 + n4; d[0] = g * v.x; d[1] = g * v.y; d[2] = g * v.z; d[3] = g * v.w; }
    LDS_WAIT(); asm volatile("" ::: "memory");
    const int c = lane & 7;
#pragma unroll
    for (int j = 0; j < 8; ++j) { const int n = (lane >> 3) + 8 * j; const LAS float* s = scr + (8 * c) * 65 + n;
        v4u o; o.x = pk2(s[0 * 65], s[1 * 65]); o.y = pk2(s[2 * 65], s[3 * 65]); o.z = pk2(s[4 * 65], s[5 * 65]); o.w = pk2(s[6 * 65], s[7 * 65]);
        *(GAS v4u*)(WT + (size_t)(colmap(mode, n0 + (n & 32)) + (n & 31)) * K + k0 + 8 * c) = o; }
    LDS_WAIT(); asm volatile("" ::: "memory");
}
__device__ __forceinline__ void p0_x_item(const float* x, bf16* xb, float* stats, int item, int lane) {
#pragma unroll
    for (int rr = 0; rr < 4; ++rr) { const int m = 4 * item + rr; float s = 0.f;
#pragma unroll
        for (int hh = 0; hh < 2; ++hh) { const float* p = x + (size_t)m * D + 512 * hh + 8 * lane; const f32x4 a = *(const GAS f32x4*)p, b = *(const GAS f32x4*)(p + 4);
            s += (a.x * a.x + a.y * a.y) + (a.z * a.z + a.w * a.w) + (b.x * b.x + b.y * b.y) + (b.z * b.z + b.w * b.w);
            v4u o; o.x = pk2(a.x, a.y); o.y = pk2(a.z, a.w); o.z = pk2(b.x, b.y); o.w = pk2(b.z, b.w); *(GAS v4u*)(xb + (size_t)m * D + 512 * hh + 8 * lane) = o; }
        s = wave_sum(s);
        if (lane < 16) stats[(size_t)m * 16 + lane] = lane == 0 ? s : 0.f; }
}
__device__ __forceinline__ void p0_prologue(Frame& F, const Args& a) {
    unsigned char* ws = a.ws;
    LAS float* scr = (LAS float*)(F.lds + RING_OFF + F.wave * 16640);
    const int gw = F.vcu * NWAVES + F.wave, NGW = F.G * NWAVES;
    constexpr int I_IN0 = (D / 64) * (N_IN0 / 64), I_SQ = (D / 64) * (D / 64), I_UP = (D / 64) * (FF / 64), I_DN = (FF / 64) * (D / 64), I_IN1 = (D / 64) * (N_IN1 / 64);
    constexpr int NW_ITEMS = I_IN0 + 2 * I_SQ + 2 * I_UP + 2 * I_DN + I_IN1, NITEMS = NW_ITEMS + M / 4;
    const float* x = a.in[0]; bf16* xb = (bf16*)(ws + WS_XB); float* stats = (float*)(ws + WS_STATS);
    for (int it = gw; it < NITEMS; it += NGW) {
        int r = it;
        if (r >= NW_ITEMS) { p0_x_item(x, xb, stats, r - NW_ITEMS, F.lane); continue; }
        if (r < I_IN0) { p0_transpose_item(a.in[3], D, N_IN0, (bf16*)(ws + WS_W_IN0), a.in[2], 1, scr, r, F.lane); continue; } r -= I_IN0;
        if (r < I_SQ) { p0_transpose_item(a.in[8], D, D, (bf16*)(ws + WS_W_OUT0), nullptr, 0, scr, r, F.lane); continue; } r -= I_SQ;
        if (r < I_UP) { p0_transpose_item(a.in[14], D, FF, (bf16*)(ws + WS_W_UP0), a.in[13], 0, scr, r, F.lane); continue; } r -= I_UP;
        if (r < I_DN) { p0_transpose_item(a.in[15], FF, D, (bf16*)(ws + WS_W_DN0), nullptr, 0, scr, r, F.lane); continue; } r -= I_DN;
        if (r < I_IN1) { p0_transpose_item(a.in[10], D, N_IN1, (bf16*)(ws + WS_W_IN1), a.in[9], 2, scr, r, F.lane); continue; } r -= I_IN1;
        if (r < I_SQ) { p0_transpose_item(a.in[12], D, D, (bf16*)(ws + WS_W_OUT1), nullptr, 0, scr, r, F.lane); continue; } r -= I_SQ;
        if (r < I_UP) { p0_transpose_item(a.in[14] + (size_t)D * FF, D, FF, (bf16*)(ws + WS_W_UP1), a.in[13] + D, 0, scr, r, F.lane); continue; } r -= I_UP;
        p0_transpose_item(a.in[15] + (size_t)FF * D, FF, D, (bf16*)(ws + WS_W_DN1), nullptr, 0, scr, r, F.lane);
    }
    if (blockIdx.x == 0) {
        float* b2 = (float*)(ws + WS_BIAS2); const float* rb = a.in[1];
        for (int i = F.tid; i < 24 * 129; i += NWAVES * 64) {
            const int gh = i / 129, m = i % 129, g = gh >> 3, n = m << (2 * g);
            int bucket = n;
            if (n >= 16) { const float nf = (float)n; const int large = 16 + (int)(logf(nf / 16.0f) / logf(128.0f) * 16.0f); bucket = large < 31 ? large : 31; }
            b2[gh * 132 + m] = LOG2E * rb[bucket * 24 + gh];
        }
    }
}

typedef float f32x16 __attribute__((ext_vector_type(16)));
typedef short s16x4 __attribute__((ext_vector_type(4)));
typedef short v4i16_t __attribute__((ext_vector_type(4)));
__device__ __forceinline__ int crow(int r, int hi) { return (r & 3) + 8 * (r >> 2) + 4 * hi; }
__device__ __forceinline__ s16x4 vtr(const LAS unsigned char* p) { return __builtin_bit_cast(s16x4, __builtin_amdgcn_ds_read_tr16_b64_v4i16((LAS v4i16_t*)p)); }
__device__ __forceinline__ unsigned cvtpk_s(float lo, float hi) { typedef float f2 __attribute__((ext_vector_type(2))); typedef __bf16 b2 __attribute__((ext_vector_type(2))); f2 v = {lo, hi}; b2 b = __builtin_convertvector(v, b2); return __builtin_bit_cast(unsigned, b); }
constexpr int ATT_UNITS = BATCH * 3 * 8 * 32;
__device__ __forceinline__ void glds16(const void* gsrc, unsigned lds_dst) { unsigned keep;
    asm volatile("s_mov_b32 %0, m0\n\ts_mov_b32 m0, %2\n\ts_nop 0\n\tglobal_load_lds_dwordx4 %1, off\n\ts_mov_b32 m0, %0" : "=&s"(keep) : "v"(gsrc), "s"(lds_dst) : "memory"); }
struct AttUnit { const bf16* Qb; const bf16* Kb; const bf16* Vb; size_t rowbase; int g, h, gh, d, j0; };
__device__ __forceinline__ AttUnit att_decode(int u, const bf16* qkv) {
    AttUnit t; const int rb = u & 31, b = u / 768; t.h = (u >> 5) & 7; t.g = (u >> 8) % 3; t.gh = t.g * 8 + t.h;
    t.d = 1 << (2 * t.g); const int lgn = 5 - 2 * t.g, r = rb >> lgn; t.j0 = (rb & ((1 << lgn) - 1)) * 256;
    t.rowbase = (size_t)b * SEQ + r;
    t.Qb = qkv + ((size_t)((t.gh * 4 + b) * 8192 + r * (SEQ >> (2 * t.g))) << 6);
    t.Kb = t.Qb + (size_t)24 * 4 * 8192 * 64; t.Vb = t.Kb + (size_t)24 * 4 * 8192 * 64; return t;
}
__device__ __forceinline__ void att_issue_k(const AttUnit& t, unsigned kl, int wave, int lane) {
#pragma unroll
    for (int k = 0; k < 6; ++k) {
        const int inst = wave * 6 + k, tr = 8 * inst + (lane >> 3); int kj = t.j0 - 128 + tr; kj = kj < 0 ? 0 : kj;
        const int c = (lane & 7) ^ ((tr >> 1) & 7);
        glds16(t.Kb + kj * 64 + c * 8, (unsigned)__builtin_amdgcn_readfirstlane((int)(kl + inst * 1024)));
    }
}
__device__ __forceinline__ void att_issue_v(const AttUnit& t, unsigned vl, int wave, int lane) {
#pragma unroll
    for (int k = 0; k < 6; ++k) {
        const int inst = wave * 6 + k, dh = inst / 24, kg = inst % 24, tr = 16 * kg + (lane >> 2); int kj = t.j0 - 128 + tr; kj = kj < 0 ? 0 : kj;
        glds16(t.Vb + kj * 64 + ((lane & 3) + 4 * dh) * 8, (unsigned)__builtin_amdgcn_readfirstlane((int)(vl + inst * 1024)));
    }
}
__device__ __forceinline__ void p2_attention(Frame& F, const Args& a) {
    const bf16* qkv = (const bf16*)(a.ws + WS_R2); bf16* og = (bf16*)((unsigned char*)a.out + OUT_OG); float* lse = (float*)(a.ws + WS_LSE); const float* b2 = (const float*)(a.ws + WS_BIAS2);
    LAS unsigned char* const KL = F.lds + AT_K; LAS unsigned char* const VL = F.lds + AT_V; LAS float* const BT = (LAS float*)(F.lds + AT_BT);
    LAS float* const wsf = (LAS float*)(F.lds + AT_WS) + F.wave * 64; LAS bf16* const stg = (LAS bf16*)(F.lds + AT_OST) + F.wave * 2048;
    const unsigned kl = (unsigned)(uintptr_t)KL, vl = (unsigned)(uintptr_t)VL;
    const int lane = F.lane, wave = F.wave, r32 = lane & 31, hi = lane >> 5;
    const int upw = (ATT_UNITS + F.G - 1) / F.G, u0 = F.vcu * upw;
    int nu = ATT_UNITS - u0; nu = nu < 0 ? 0 : (nu > upw ? upw : nu);
    if (nu == 0) return;
    int prev_gh = -1;
    const int vlane = ((lane >> 4) & 1) * 32 + (lane & 3) * 8 + (4 * hi + ((lane & 15) >> 2)) * 64;
    AttUnit cur = att_decode(u0, qkv);
    att_issue_k(cur, kl, wave, lane);
    pg8::bf16x8 qn[4];
    { const bf16* qp = cur.Qb + (cur.j0 + 32 * wave + r32) * 64 + hi * 8;
#pragma unroll
      for (int d0 = 0; d0 < 4; ++d0) qn[d0] = *(const pg8::bf16x8*)(qp + d0 * 16); }
    asm volatile("" : "+v"(qn[0]), "+v"(qn[1]), "+v"(qn[2]), "+v"(qn[3]));
    for (int i = 0; i < nu; ++i) {
        const bool has_next = (i + 1 < nu);
        const AttUnit nxt = att_decode(has_next ? u0 + i + 1 : u0 + i, qkv);
        const int g = cur.g, h = cur.h, d = cur.d, j0 = cur.j0; const size_t rowbase = cur.rowbase;
        if (cur.gh != prev_gh) {
            prev_gh = cur.gh;
            for (int e = F.tid; e < 5 * 4 * 64 * 4; e += NWAVES * 64) {
                const int ii = e & 3, L = (e >> 2) & 63, r4 = (e >> 8) & 3, kb = e >> 10, q = L & 31, hh = L >> 5;
                const int m = 128 - 32 * kb + q - (8 * r4 + 4 * hh + ii);
                BT[e] = (m >= 0 && m <= 128) ? b2[cur.gh * 132 + m] : -1e30f;
            }
        }
        asm volatile("s_waitcnt vmcnt(0) lgkmcnt(0)\n\ts_barrier" ::: "memory");
        att_issue_v(cur, vl, wave, lane);
        pg8::bf16x8 qr[4];
#pragma unroll
        for (int d0 = 0; d0 < 4; ++d0) qr[d0] = qn[d0];
        if (has_next) { const bf16* qp = nxt.Qb + (nxt.j0 + 32 * wave + r32) * 64 + hi * 8;
#pragma unroll
            for (int d0 = 0; d0 < 4; ++d0) qn[d0] = *(const pg8::bf16x8*)(qp + d0 * 16); }
        f32x16 S[5];
        const bool first = (j0 == 0);
#pragma unroll
        for (int kb = 0; kb < 5; ++kb) {
            f32x16 acc;
#pragma unroll
            for (int r4 = 0; r4 < 4; ++r4) { const f32x4 t = *(const LAS f32x4*)(BT + ((kb * 4 + r4) * 64 + lane) * 4); acc[4 * r4 + 0] = t[0]; acc[4 * r4 + 1] = t[1]; acc[4 * r4 + 2] = t[2]; acc[4 * r4 + 3] = t[3]; }
            const int trow = 32 * (wave + kb) + r32;
#pragma unroll
            for (int d0 = 0; d0 < 4; ++d0) {
                const pg8::bf16x8 kf = *(const LAS pg8::bf16x8*)(KL + trow * 128 + (((2 * d0 + hi) ^ ((trow >> 1) & 7)) << 4));
                acc = __builtin_amdgcn_mfma_f32_32x32x16_bf16(kf, qr[d0], acc, 0, 0, 0);
            }
            if (first && kb < 4 - wave) {
#pragma unroll
                for (int rr = 0; rr < 16; ++rr) acc[rr] = -1e30f;
            }
            S[kb] = acc;
        }
        float mx = S[0][0];
#pragma unroll
        for (int kb = 0; kb < 5; ++kb)
#pragma unroll
            for (int rr = 0; rr < 16; ++rr) mx = fmaxf(mx, S[kb][rr]);
        { auto sw = __builtin_amdgcn_permlane32_swap(__float_as_uint(mx), __float_as_uint(mx), false, false); mx = fmaxf(__uint_as_float(sw[0]), __uint_as_float(sw[1])); }
        float lsum = 0.f;
#pragma unroll
        for (int kb = 0; kb < 5; ++kb)
#pragma unroll
            for (int rr = 0; rr < 16; ++rr) { const float p = __builtin_amdgcn_exp2f(S[kb][rr] - mx); S[kb][rr] = p; lsum += p; }
        { auto sw = __builtin_amdgcn_permlane32_swap(__float_as_uint(lsum), __float_as_uint(lsum), false, false); lsum = __uint_as_float(sw[0]) + __uint_as_float(sw[1]); }
        asm volatile("" : "+v"(qn[0]), "+v"(qn[1]), "+v"(qn[2]), "+v"(qn[3]));
        asm volatile("s_waitcnt lgkmcnt(0)\n\ts_barrier" ::: "memory");
        if (has_next) { att_issue_k(nxt, kl, wave, lane); asm volatile("s_waitcnt vmcnt(6)\n\ts_barrier" ::: "memory"); }
        else asm volatile("s_waitcnt vmcnt(0)\n\ts_barrier" ::: "memory");
        f32x16 o[2]; o[0] = f32x16{}; o[1] = f32x16{};
#pragma unroll
        for (int kb = 0; kb < 5; ++kb)
#pragma unroll
            for (int s = 0; s < 2; ++s) {
                v4u pw; pw.x = cvtpk_s(S[kb][8 * s + 0], S[kb][8 * s + 1]); pw.y = cvtpk_s(S[kb][8 * s + 2], S[kb][8 * s + 3]); pw.z = cvtpk_s(S[kb][8 * s + 4], S[kb][8 * s + 5]); pw.w = cvtpk_s(S[kb][8 * s + 6], S[kb][8 * s + 7]);
                const pg8::bf16x8 pa = __builtin_bit_cast(pg8::bf16x8, pw);
                const int kg = 2 * (wave + kb) + s;
#pragma unroll
                for (int d0 = 0; d0 < 2; ++d0) {
                    const LAS unsigned char* vp = VL + (d0 * 24 + kg) * 1024 + vlane;
                    const s16x4 lo = vtr(vp), hh = vtr(vp + 512);
                    const pg8::bf16x8 vb = (pg8::bf16x8){lo[0], lo[1], lo[2], lo[3], hh[0], hh[1], hh[2], hh[3]};
                    o[d0] = __builtin_amdgcn_mfma_f32_32x32x16_bf16(pa, vb, o[d0], 0, 0, 0);
                }
            }
        if (hi == 0) { wsf[r32] = __builtin_amdgcn_rcpf(lsum); lse[((size_t)g * M + rowbase + (size_t)d * (j0 + 32 * wave + r32)) * 8 + h] = mx + __builtin_amdgcn_logf(lsum); }
        asm volatile("s_waitcnt lgkmcnt(0)" ::: "memory");
#pragma unroll
        for (int rr = 0; rr < 16; ++rr) { const int orow = crow(rr, hi); const float il = wsf[orow];
            stg[orow * 64 + r32] = (bf16)f2bf(o[0][rr] * il); stg[orow * 64 + 32 + r32] = (bf16)f2bf(o[1][rr] * il); }
        asm volatile("s_waitcnt lgkmcnt(0)" ::: "memory");
        bf16* ob = og + (size_t)g * M * 512 + h * 64;
#pragma unroll
        for (int k = 0; k < 4; ++k) { const int row = k * 8 + (lane >> 3), ch = lane & 7; const v4u v = *(const LAS v4u*)(stg + row * 64 + ch * 8);
            *(v4u*)(ob + (rowbase + (size_t)d * (j0 + 32 * wave + row)) * 512 + ch * 8) = v; }
        asm volatile("s_waitcnt lgkmcnt(0)" ::: "memory");
        cur = nxt;
    }
    asm volatile("s_waitcnt vmcnt(0) lgkmcnt(0)\n\ts_barrier" ::: "memory");
}

constexpr int P3_TB = 32, P3_ROWS = P3_TB + CONVW - 1, P3_DT = 0, P3_WT = 65536, P3_UNITS = M / P3_TB;
typedef float f32x2 __attribute__((ext_vector_type(2)));
__device__ __forceinline__ void p3_conv_cat(Frame& F, const Args& a) {
    const bf16* hg = (const bf16*)((unsigned char*)a.out + OUT_HGLU); const bf16* yb = (const bf16*)((unsigned char*)a.out + OUT_OG); const float* lse = (const float*)(a.ws + WS_LSE); bf16* cat = (bf16*)(a.ws + WS_R2);
    const float* cw = a.in[4]; const float* cb = a.in[5]; const float* lg = a.in[6]; const float* lb = a.in[7];
    const int lane = F.lane, wave = F.wave, c0 = 8 * lane;
    LAS unsigned char* const DT = F.lds + P3_DT; LAS unsigned char* const WT = F.lds + P3_WT;
    for (int j = wave; j < 2 * CONVW; j += NWAVES)
        __builtin_amdgcn_global_load_lds((const unsigned*)(cw + (j >> 1) * CA + c0 + 4 * (j & 1)), (LAS unsigned*)(WT + j * 1024), 16, 0, 0);
    f32x2 bias2v[4], gam[4], bet[4];
#pragma unroll
    for (int q = 0; q < 4; ++q) { bias2v[q] = *(const f32x2*)(cb + c0 + 2 * q); gam[q] = *(const f32x2*)(lg + c0 + 2 * q); bet[q] = *(const f32x2*)(lb + c0 + 2 * q); }
    const int upw = (P3_UNITS + F.G - 1) / F.G;
    for (int i = 0; i < upw; ++i) {
        const int u = F.vcu * upw + i; if (u >= P3_UNITS) break;
        const int t0 = u * P3_TB, ts = t0 & (SEQ - 1);
        for (int r = wave; r < P3_ROWS; r += NWAVES) {
            if (ts - (CONVW - 1) + r >= 0) __builtin_amdgcn_global_load_lds((const unsigned*)(hg + (size_t)(t0 - (CONVW - 1) + r) * CA + c0), (LAS unsigned*)(DT + r * 1024), 16, 0, 0);
            else *(LAS v4u*)(DT + r * 1024 + lane * 16) = (v4u){0u, 0u, 0u, 0u};
        }
        const int hh = lane >> 3; float l3[4][3]; v4u og3[4][3];
#pragma unroll
        for (int j = 0; j < 4; ++j) { const size_t row = (size_t)t0 + 4 * wave + j;
#pragma unroll
            for (int g = 0; g < 3; ++g) { l3[j][g] = lse[((size_t)g * M + row) * 8 + hh]; og3[j][g] = *(const v4u*)(yb + ((size_t)g * M + row) * 512 + c0); } }
        asm volatile("s_waitcnt vmcnt(0)" ::: "memory");
        __syncthreads();
        f32x2 acc[4][4];
#pragma unroll
        for (int j = 0; j < 4; ++j)
#pragma unroll
            for (int q = 0; q < 4; ++q) acc[j][q] = bias2v[q];
        f32x2 wv[4][4];
#pragma unroll
        for (int r = 0; r < P3_TB / NWAVES + CONVW - 1; ++r) {
            const v4u d = *(const LAS v4u*)(DT + (4 * wave + r) * 1024 + lane * 16);
            const f32x2 x0 = {bflo(d.x), bfhi(d.x)}, x1 = {bflo(d.y), bfhi(d.y)}, x2 = {bflo(d.z), bfhi(d.z)}, x3 = {bflo(d.w), bfhi(d.w)};
            if (r < CONVW) { const f32x4 w0 = *(const LAS f32x4*)(WT + (2 * r) * 1024 + lane * 16), w1 = *(const LAS f32x4*)(WT + (2 * r + 1) * 1024 + lane * 16);
                wv[r & 3][0] = (f32x2){w0[0], w0[1]}; wv[r & 3][1] = (f32x2){w0[2], w0[3]}; wv[r & 3][2] = (f32x2){w1[0], w1[1]}; wv[r & 3][3] = (f32x2){w1[2], w1[3]}; }
#pragma unroll
            for (int j = 0; j < 4; ++j) { const int k = r - j;
                if (k >= 0 && k < CONVW) { acc[j][0] += wv[k & 3][0] * x0; acc[j][1] += wv[k & 3][1] * x1; acc[j][2] += wv[k & 3][2] * x2; acc[j][3] += wv[k & 3][3] * x3; } }
        }
#pragma unroll
        for (int j = 0; j < 4; ++j) {
            const size_t row = (size_t)t0 + 4 * wave + j;
            float s = (acc[j][0][0] + acc[j][0][1]) + (acc[j][1][0] + acc[j][1][1]) + (acc[j][2][0] + acc[j][2][1]) + (acc[j][3][0] + acc[j][3][1]);
            const float mu = wave_sum(s) * (1.0f / CA); float qq = 0.f;
#pragma unroll
            for (int q = 0; q < 4; ++q) { acc[j][q] -= mu; qq += acc[j][q][0] * acc[j][q][0] + acc[j][q][1] * acc[j][q][1]; }
            const float rstd = __builtin_amdgcn_rsqf(wave_sum(qq) * (1.0f / CA) + LN_EPS);
            float y[8];
#pragma unroll
            for (int q = 0; q < 4; ++q) { const f32x2 v = acc[j][q] * rstd * gam[q] + bet[q];
                y[2 * q] = v[0] * __builtin_amdgcn_rcpf(1.0f + __builtin_amdgcn_exp2f(-LOG2E * v[0])); y[2 * q + 1] = v[1] * __builtin_amdgcn_rcpf(1.0f + __builtin_amdgcn_exp2f(-LOG2E * v[1])); }
            v4u o; o.x = pk2(y[0], y[1]); o.y = pk2(y[2], y[3]); o.z = pk2(y[4], y[5]); o.w = pk2(y[6], y[7]);
            *(v4u*)(cat + row * D + c0) = o;
            const float lm = fmaxf(l3[j][0], fmaxf(l3[j][1], l3[j][2])); float w0 = __builtin_amdgcn_exp2f(l3[j][0] - lm), w1 = __builtin_amdgcn_exp2f(l3[j][1] - lm), w2 = __builtin_amdgcn_exp2f(l3[j][2] - lm);
            const float iw = __builtin_amdgcn_rcpf(w0 + w1 + w2); w0 *= iw; w1 *= iw; w2 *= iw;
            const v4u a0 = og3[j][0], a1 = og3[j][1], a2 = og3[j][2]; v4u rr;
            rr.x = pk2(w0 * bflo(a0.x) + w1 * bflo(a1.x) + w2 * bflo(a2.x), w0 * bfhi(a0.x) + w1 * bfhi(a1.x) + w2 * bfhi(a2.x));
            rr.y = pk2(w0 * bflo(a0.y) + w1 * bflo(a1.y) + w2 * bflo(a2.y), w0 * bfhi(a0.y) + w1 * bfhi(a1.y) + w2 * bfhi(a2.y));
            rr.z = pk2(w0 * bflo(a0.z) + w1 * bflo(a1.z) + w2 * bflo(a2.z), w0 * bfhi(a0.z) + w1 * bfhi(a1.z) + w2 * bfhi(a2.z));
            rr.w = pk2(w0 * bflo(a0.w) + w1 * bflo(a1.w) + w2 * bflo(a2.w), w0 * bfhi(a0.w) + w1 * bfhi(a1.w) + w2 * bfhi(a2.w));
            *(v4u*)(cat + row * D + CA + c0) = rr;
        }
        asm volatile("s_waitcnt lgkmcnt(0)" ::: "memory");
        __syncthreads();
    }
}

__device__ __forceinline__ void p8_shortconv(Frame& F, const Args& a) {
    const bf16* bg = (const bf16*)(a.ws + WS_R2); const bf16* cv = (const bf16*)(a.ws + WS_R2 + 64 * MiB); bf16* y = (bf16*)(a.ws + WS_R2 + 128 * MiB);
    const float* w = a.in[11];
    const int c0 = 8 * (F.tid & 127), rsub = F.tid >> 7;
    f32x2 wk[3][4];
#pragma unroll
    for (int k = 0; k < 3; ++k)
#pragma unroll
        for (int q = 0; q < 4; ++q) wk[k][q] = *(const f32x2*)(w + k * D + c0 + 2 * q);
    constexpr int NU = M / 32; const int upw = (NU + F.G - 1) / F.G;
    for (int i = 0; i < upw; ++i) {
        const int u = F.vcu * upw + i; if (u >= NU) break;
        const int r0 = u * 32 + rsub * 8, t = r0 & (SEQ - 1);
        v4u xc[10], xb8[8];
#pragma unroll
        for (int j = 0; j < 10; ++j) xc[j] = (t + j - 2 >= 0) ? *(const v4u*)(cv + (size_t)(r0 + j - 2) * D + c0) : (v4u){0u, 0u, 0u, 0u};
#pragma unroll
        for (int j = 0; j < 8; ++j) xb8[j] = *(const v4u*)(bg + (size_t)(r0 + j) * D + c0);
#pragma unroll
        for (int j = 0; j < 8; ++j) {
            f32x2 acc[4] = {{0.f, 0.f}, {0.f, 0.f}, {0.f, 0.f}, {0.f, 0.f}};
#pragma unroll
            for (int k = 0; k < 3; ++k) { const v4u x = xc[j + k];
                acc[0] += wk[k][0] * (f32x2){bflo(x.x), bfhi(x.x)}; acc[1] += wk[k][1] * (f32x2){bflo(x.y), bfhi(x.y)}; acc[2] += wk[k][2] * (f32x2){bflo(x.z), bfhi(x.z)}; acc[3] += wk[k][3] * (f32x2){bflo(x.w), bfhi(x.w)}; }
            const v4u b = xb8[j];
            v4u o; o.x = pk2(acc[0][0] * bflo(b.x), acc[0][1] * bfhi(b.x)); o.y = pk2(acc[1][0] * bflo(b.y), acc[1][1] * bfhi(b.y)); o.z = pk2(acc[2][0] * bflo(b.z), acc[2][1] * bfhi(b.z)); o.w = pk2(acc[3][0] * bflo(b.w), acc[3][1] * bfhi(b.w));
            *(v4u*)(y + (size_t)(r0 + j) * D + c0) = o;
        }
    }
}

__device__ __forceinline__ void p12_final_norm(Frame& F, const Args& a) {
    const float* stats = (const float*)(a.ws + WS_STATS); const bf16* xb = (const bf16*)(a.ws + WS_XB); const float* g = a.in[16]; float* out = a.out;
    const int gw = F.vcu * NWAVES + F.wave, NGW = F.G * NWAVES;
    f32x4 gv[4];
#pragma unroll
    for (int j = 0; j < 4; ++j) gv[j] = *(const f32x4*)(g + 8 * F.lane + 512 * (j >> 1) + 4 * (j & 1));
    for (int row = gw; row < M; row += NGW) {
        float s = stats[(size_t)row * 16 + (F.lane & 15)];
        s += __shfl_xor(s, 1); s += __shfl_xor(s, 2); s += __shfl_xor(s, 4); s += __shfl_xor(s, 8);
        const float rstd = 1.0f / sqrtf(s * (1.0f / D) + RMS_EPS);
#pragma unroll
        for (int j = 0; j < 2; ++j) {
            const v4u w = *(const v4u*)(xb + (size_t)row * D + 8 * F.lane + 512 * j);
            const f32x4 v0 = (f32x4){bflo(w.x), bfhi(w.x), bflo(w.y), bfhi(w.y)}, v1 = (f32x4){bflo(w.z), bfhi(w.z), bflo(w.w), bfhi(w.w)};
            float* o = out + (size_t)row * D + 8 * F.lane + 512 * j;
            *(f32x4*)o = v0 * rstd * gv[2 * j]; *(f32x4*)(o + 4) = v1 * rstd * gv[2 * j + 1];
        }
    }
}

__device__ __forceinline__ void rstab_fill(Frame& F, const pg8::StaticOrder& S, const float* stats) {
    LAS float* tab = (LAS float*)(F.lds + RSTAB_OFF); pg8::Unit u;
    if (F.tid < 256)
        for (int i = 0; S.next(i, u); ++i) {
            const f32x4* p = (const f32x4*)(stats + (size_t)(u.pm * 256 + F.tid) * 16);
            const f32x4 a = p[0], b = p[1], c = p[2], d = p[3];
            const float s = ((a[0] + a[1]) + (a[2] + a[3])) + ((b[0] + b[1]) + (b[2] + b[3])) + ((c[0] + c[1]) + (c[2] + c[3])) + ((d[0] + d[1]) + (d[2] + d[3]));
            tab[i * 256 + F.tid] = __builtin_amdgcn_rsqf(s * (1.0f / D) + RMS_EPS) * pg8::KSC;
        }
    __syncthreads();
}
#ifndef STAG_TICKS
#define STAG_TICKS 0
#endif
__device__ __forceinline__ void stagger(int ticks) {
    if (ticks > 0 && ((blockIdx.x >> 3) & 1)) { const unsigned long long t0 = __builtin_amdgcn_s_memrealtime(); while (__builtin_amdgcn_s_memrealtime() - t0 < (unsigned long long)ticks) __builtin_amdgcn_s_sleep(32); }
}
__global__ void __launch_bounds__(NWAVES * 64, 2) hybrid_fwd(Args args) {
    extern __shared__ __attribute__((aligned(16))) unsigned char lds[];
    Frame F;
    F.lds = (LAS unsigned char*)lds;
    F.MISC = (volatile LAS unsigned*)(F.lds + MISC_OFF);
    F.tid = threadIdx.x; F.lane = F.tid & 63; F.wave = __builtin_amdgcn_readfirstlane(F.tid >> 6);
    F.G = gridDim.x; { const int bx = blockIdx.x; F.vcu = (F.G % 8 == 0) ? (bx % 8) * (F.G / 8) + bx / 8 : bx; }
    unsigned char* ws = args.ws;
    F.ctl = (gu32*)(ws + WS_CTL);
    for (int u = F.tid; u < (LDS_BYTES - LDSCTL_OFF) / 4; u += NWAVES * 64) ((LAS unsigned*)(F.lds + LDSCTL_OFF))[u] = 0u;
    __syncthreads();
    XcdBarrier bar; bar.bar = (unsigned*)(F.ctl + CW_BAR); bar.x = 0; bar.st = nullptr;
    if (N_LAUNCHES == 1) bar = xcd_barrier_post((unsigned*)(F.ctl + CW_BAR), F.MISC + 8);
#ifndef PROBE_BAR2
#define PROBE_BAR2 0
#endif
#define GRID_BAR() do { if (N_LAUNCHES == 1) { xcd_barrier(bar); if (PROBE_BAR2) xcd_barrier(bar); } } while (0)
    const int lo = args.ph_lo, hi = args.ph_hi;
#define IN(k) (lo <= (k) && (k) < hi)
#define BOTH(k) (IN(k) && IN((k) + 1))
    bf16* const xb = (bf16*)(ws + WS_XB); float* const stats = (float*)(ws + WS_STATS);
    bf16* const r2 = (bf16*)(ws + WS_R2);

    if (IN(0)) { REPS(0) { p0_prologue(F, args); } if (BOTH(0)) GRID_BAR(); }
    if (IN(1)) {
        stagger(STAG_TICKS);
        REPS(1) {
        pg8::Gemm g{xb, (const bf16*)(ws + WS_W_IN0), M, N_IN0, D}; pg8::StaticOrder S; S.init(M, N_IN0, F.G, (int)blockIdx.x);
        rstab_fill(F, S, stats);
        pg8::EpiIn0 E{(bf16*)((unsigned char*)args.out + OUT_HGLU), r2, (const LAS float*)(F.lds + RSTAB_OFF), QSCALE, F.lds + ESTG_OFF};
        pg8::gemm_phase<pg8::EpiIn0, pg8::StaticOrder, PG8_ALIGN, PG8_SP2>(F.lds + RING_OFF, g, S, E);
        }
        if (BOTH(1)) GRID_BAR();
    }
    if (IN(2)) { REPS(2) { p2_attention(F, args); } if (BOTH(2)) GRID_BAR(); }
    if (IN(3)) { REPS(3) { p3_conv_cat(F, args); } if (BOTH(3)) GRID_BAR(); }
    if (IN(4)) {
        REPS(4) {
        pg8::Gemm g{r2, (const bf16*)(ws + WS_W_OUT0), M, D, D}; pg8::StaticOrder S; S.init(M, D, F.G, (int)blockIdx.x);
        pg8::EpiRes E{xb, stats};
        pg8::gemm_phase<pg8::EpiRes, pg8::StaticOrder, PG8_ALIGN, PG8_SP2>(F.lds + RING_OFF, g, S, E);
        }
        if (BOTH(4)) GRID_BAR();
    }
    if (IN(5)) {
        stagger(STAG_TICKS);
        REPS(5) {
        pg8::Gemm g{xb, (const bf16*)(ws + WS_W_UP0), M, FF, D}; pg8::StaticOrder S; S.init(M, FF, F.G, (int)blockIdx.x);
        rstab_fill(F, S, stats);
        pg8::EpiUp E{r2, (const LAS float*)(F.lds + RSTAB_OFF), F.lds + ESTG_OFF};
        pg8::gemm_phase<pg8::EpiUp, pg8::StaticOrder, PG8_ALIGN, PG8_SP2>(F.lds + RING_OFF, g, S, E);
        }
        if (BOTH(5)) GRID_BAR();
    }
    if (IN(6)) {
        REPS(6) {
        pg8::Gemm g{r2, (const bf16*)(ws + WS_W_DN0), M, D, FF}; pg8::StaticOrder S; S.init(M, D, F.G, (int)blockIdx.x);
        pg8::EpiRes E{xb, stats};
        pg8::gemm_phase<pg8::EpiRes, pg8::StaticOrder, PG8_ALIGN, PG8_SP2>(F.lds + RING_OFF, g, S, E);
        }
        if (BOTH(6)) GRID_BAR();
    }
    if (IN(7)) {
        stagger(STAG_TICKS);
        REPS(7) {
        pg8::Gemm g{xb, (const bf16*)(ws + WS_W_IN1), M, N_IN1, D}; pg8::StaticOrder S; S.init(M, N_IN1, F.G, (int)blockIdx.x);
        rstab_fill(F, S, stats);
        pg8::EpiIn1 E{(bf16*)(ws + WS_R2 + 64 * MiB), r2, (const LAS float*)(F.lds + RSTAB_OFF), F.lds + ESTG_OFF};
        pg8::gemm_phase<pg8::EpiIn1, pg8::StaticOrder, PG8_ALIGN, PG8_SP2>(F.lds + RING_OFF, g, S, E);
        }
        if (BOTH(7)) GRID_BAR();
    }
    if (IN(8)) { REPS(8) { p8_shortconv(F, args); } if (BOTH(8)) GRID_BAR(); }
    if (IN(9)) {
        REPS(9) {
        pg8::Gemm g{(const bf16*)(ws + WS_R2 + 128 * MiB), (const bf16*)(ws + WS_W_OUT1), M, D, D}; pg8::StaticOrder S; S.init(M, D, F.G, (int)blockIdx.x);
        pg8::EpiRes E{xb, stats};
        pg8::gemm_phase<pg8::EpiRes, pg8::StaticOrder, PG8_ALIGN, PG8_SP2>(F.lds + RING_OFF, g, S, E);
        }
        if (BOTH(9)) GRID_BAR();
    }
    if (IN(10)) {
        stagger(STAG_TICKS);
        REPS(10) {
        pg8::Gemm g{xb, (const bf16*)(ws + WS_W_UP1), M, FF, D}; pg8::StaticOrder S; S.init(M, FF, F.G, (int)blockIdx.x);
        rstab_fill(F, S, stats);
        pg8::EpiUp E{r2, (const LAS float*)(F.lds + RSTAB_OFF), F.lds + ESTG_OFF};
        pg8::gemm_phase<pg8::EpiUp, pg8::StaticOrder, PG8_ALIGN, PG8_SP2>(F.lds + RING_OFF, g, S, E);
        }
        if (BOTH(10)) GRID_BAR();
    }
    if (IN(11)) {
        REPS(11) {
        pg8::Gemm g{r2, (const bf16*)(ws + WS_W_DN1), M, D, FF}; pg8::StaticOrder S; S.init(M, D, F.G, (int)blockIdx.x);
#if FUSE_FINAL
        pg8::EpiFinal E{xb, args.out, args.in[16], stats, (unsigned*)(F.ctl + CW_SEAM), (unsigned*)(F.ctl + CW_TMO), F.lds + RING_BYTES};
        pg8::gemm_phase<pg8::EpiFinal, pg8::StaticOrder, true, PG8_SP2>(F.lds + RING_OFF, g, S, E);
#else
        pg8::EpiRes E{xb, stats};
        pg8::gemm_phase<pg8::EpiRes, pg8::StaticOrder, PG8_ALIGN, PG8_SP2>(F.lds + RING_OFF, g, S, E);
#endif
        }
        if (BOTH(11)) GRID_BAR();
    }
#if !FUSE_FINAL
    if (IN(12)) { p12_final_norm(F, args); }
#endif
#undef IN
#undef BOTH
}

extern "C" void kernel_launch(void* const* d_in, const int* in_sizes, int n_in, void* d_out, int out_size, void* d_ws, size_t ws_size, hipStream_t stream) {
    static int grid = 0;
    if (grid == 0) {
        if (n_in != 17 || in_sizes[0] != M * D || out_size != M * D || ws_size < WS_END) { fprintf(stderr, "kernel_launch: shape/workspace mismatch (n_in %d in0 %d out %d ws %zu, need %zu)\n", n_in, n_in > 0 ? in_sizes[0] : -1, out_size, ws_size, (size_t)WS_END); grid = -1; return; }
        int dev = 0, cus = 0, per_cu = 0;
        if (hipGetDevice(&dev) != hipSuccess || hipDeviceGetAttribute(&cus, hipDeviceAttributeMultiprocessorCount, dev) != hipSuccess) { grid = -1; return; }
        if (hipFuncSetAttribute((const void*)hybrid_fwd, hipFuncAttributeMaxDynamicSharedMemorySize, LDS_BYTES) != hipSuccess) { fprintf(stderr, "kernel_launch: hipFuncSetAttribute failed\n"); grid = -1; return; }
        if (hipOccupancyMaxActiveBlocksPerMultiprocessor(&per_cu, (const void*)hybrid_fwd, NWAVES * 64, LDS_BYTES) != hipSuccess || per_cu < 1) { fprintf(stderr, "kernel_launch: occupancy query says %d workgroups per CU\n", per_cu); }
        (void)hipGetLastError();
        grid = cus;
    }
    if (grid < 0) return;
    if (hipMemsetAsync((char*)d_ws + WS_CTL, 0, CTL_ZERO_BYTES, stream) != hipSuccess) return;
    Args a{};
    for (int i = 0; i < 17; ++i) a.in[i] = (const float*)d_in[i];
    a.out = (float*)d_out; a.ws = (unsigned char*)d_ws;
    for (int li = 0; li < N_LAUNCHES; ++li) {
        a.ph_lo = (N_LAUNCHES == 1) ? 0 : li; a.ph_hi = (N_LAUNCHES == 1) ? N_PHASES : li + 1; a.li = li;
        hipLaunchKernelGGL(hybrid_fwd, dim3(grid), dim3(NWAVES * 64), LDS_BYTES, stream, a);
    }
}
```

```cpp
#include <hip/hip_runtime.h>
#include <cstdio>
#include <cstdint>
namespace pg8 {
#define PG8_LAS __attribute__((address_space(3)))
typedef unsigned short bf16_t;
typedef short bf16x8 __attribute__((ext_vector_type(8)));
typedef float f32x4 __attribute__((ext_vector_type(4)));
typedef unsigned u32x4 __attribute__((ext_vector_type(4)));
constexpr int BM = 256, BK = 64, HALF = 128, HTB = HALF * BK * 2  , STAGE_BYTES = 8 * HTB, NXCD = 8, WGM = 8;

__host__ __device__ __forceinline__ int lds_byte(int r, int c) { const int st = (r >> 4) * 2 + (c >> 5), rr = r & 15, cc = c & 31, ob = rr * 64 + cc * 2; return st * 1024 + (ob ^ (((ob >> 9) & 1) << 5)); }
__host__ __device__ __forceinline__ void stage_rc(int b, int& R, int& C) { const int st = b / 1024, sb = b % 1024, swz = sb ^ (((sb >> 9) & 1) << 5); R = (st >> 1) * 16 + swz / 64; C = (st & 1) * 32 + (swz % 64) / 2; }
__host__ __device__ __forceinline__ int perm32(int rho) { const int n = rho >> 4, i = rho & 15; return 8 * (i >> 2) + 4 * n + (i & 3); }

struct Unit { int pm, pn, idx; };
struct Gemm { const bf16_t* A; const bf16_t* Bt; int M, N, K; };

struct StaticOrder {
    int nM, nN, nwg, G, c;
    __host__ __device__ void init(int M, int N, int G_, int c_) { nM = M / BM; nN = N / BM; nwg = nM * nN; G = G_; c = c_; }
    __host__ __device__ bool next(int i, Unit& u) const {
        const long L = (long)i * G + c; if (L >= nwg) return false;
        int wgid = (int)L; { const int q = nwg / NXCD, r = nwg % NXCD, xcd = wgid % NXCD, off = wgid / NXCD; wgid = (xcd < r ? xcd * (q + 1) : r * (q + 1) + (xcd - r) * q) + off; }
        const int nig = WGM * nN, gid = wgid / nig, fm = gid * WGM, gsz = (nM - fm) < WGM ? (nM - fm) : WGM;
        u.pm = fm + ((wgid % nig) % gsz); u.pn = (wgid % nig) / gsz; u.idx = i; return true;
    }
    __device__ __forceinline__ void a_ready(const Unit&) const {}
    __device__ __forceinline__ void done(const Unit&) const {}
};
__device__ __forceinline__ unsigned cvt_pk_bf16(float lo, float hi) { unsigned r; asm volatile("v_cvt_pk_bf16_f32 %0, %1, %2" : "=v"(r) : "v"(lo), "v"(hi)); return r; }
typedef float f32x2 __attribute__((ext_vector_type(2)));
#if defined(PROBE_KREP)
constexpr float KSC = 1.0f / PROBE_KREP;
#else
constexpr float KSC = 1.0f;
#endif
__device__ __forceinline__ void row_rstd(const PG8_LAS float* rstab, const Unit& u, int wr, int fr, float (&rs)[2][4]) {
#pragma unroll
    for (int ai = 0; ai < 2; ++ai)
#pragma unroll
        for (int m = 0; m < 4; ++m) rs[ai][m] = rstab[u.idx * BM + ai * HALF + wr * 64 + m * 16 + fr];
}
__device__ __forceinline__ u32x4 pack8(const f32x4 a, const f32x4 b) { u32x4 w; w.x = cvt_pk_bf16(a[0], a[1]); w.y = cvt_pk_bf16(a[2], a[3]); w.z = cvt_pk_bf16(b[0], b[1]); w.w = cvt_pk_bf16(b[2], b[3]); return w; }
#ifndef EPI_ST_SC1
#define EPI_ST_SC1 0
#endif
__device__ __forceinline__ void st16(bf16_t* p, const u32x4 v) {
#if EPI_ST_SC1
    asm volatile("global_store_dwordx4 %0, %1, off sc1\n\ts_nop 1" :: "v"(p), "v"(v) : "memory");
#else
    *(u32x4*)p = v;
#endif
}
__device__ __forceinline__ void stage16(PG8_LAS unsigned char* stg, int fr, int fq, const u32x4 v0, const u32x4 v1, u32x4& r0, u32x4& r1) {
    const int lane = fr + 16 * fq, x = fr & 7;
    *(PG8_LAS u32x4*)(stg + fr * 128 + ((fq ^ x) << 4)) = v0; *(PG8_LAS u32x4*)(stg + fr * 128 + (((4 + fq) ^ x) << 4)) = v1;
    const int rr = lane >> 3, c = lane & 7;
    r0 = *(const PG8_LAS u32x4*)(stg + rr * 128 + ((c ^ rr) << 4)); r1 = *(const PG8_LAS u32x4*)(stg + (rr + 8) * 128 + ((c ^ rr) << 4));
}
__device__ __forceinline__ float sigmoidf_(float g) { return __builtin_amdgcn_rcpf(1.0f + __builtin_amdgcn_exp2f(-1.4426950408889634f * g)); }

struct EpiIn0 {
    static constexpr bool WCOLS64 = true, PERM = true, AFTER_DRAIN = false, IDEMP = false;
    bf16_t* hglu; bf16_t* qkv; const PG8_LAS float* rstab; float qscale; PG8_LAS unsigned char* stg0;
    __device__ __forceinline__ void operator()(const f32x4 (&acc)[2][2][4][2], const Unit& u, int wr, int wc, int fr, int fq) const {
        const int row0 = u.pm * BM + wr * 64 + fr;
        float rs[2][4]; row_rstd(rstab, u, wr, fr, rs);
        if (u.pn < 4) {
            const int col0 = u.pn * 128 + wc * 32 + 8 * fq;
#pragma unroll
            for (int ai = 0; ai < 2; ++ai)
#pragma unroll
                for (int m = 0; m < 4; ++m) {
                    const float r = rs[ai][m];
                    f32x4 v0 = acc[ai][0][m][0] * r, v1 = acc[ai][0][m][1] * r; const f32x4 g0 = acc[ai][1][m][0] * r, g1 = acc[ai][1][m][1] * r;
#pragma unroll
                    for (int j = 0; j < 4; ++j) { v0[j] *= sigmoidf_(g0[j]); v1[j] *= sigmoidf_(g1[j]); }
                    st16(hglu + (size_t)(row0 + ai * HALF + m * 16) * 512 + col0, pack8(v0, v1));
                }
        } else {
            const int colt = (u.pn - 4) * BM; const float sc = colt < 1536 ? qscale : 1.0f; const int g2 = 2 * ((colt >> 9) % 3), plane = (colt >> 6) + wc;
            PG8_LAS unsigned char* stg = stg0 + (wr * 4 + wc) * 2048; const int lane = fr + 16 * fq, rr = lane >> 3, c = lane & 7;
#pragma unroll
            for (int ai = 0; ai < 2; ++ai)
#pragma unroll
                for (int m = 0; m < 4; ++m) {
                    const float r = rs[ai][m] * sc; u32x4 o0, o1;
                    stage16(stg, fr, fq, pack8(acc[ai][0][m][0] * r, acc[ai][0][m][1] * r), pack8(acc[ai][1][m][0] * r, acc[ai][1][m][1] * r), o0, o1);
#pragma unroll
                    for (int k = 0; k < 2; ++k) { const int row = u.pm * BM + ai * HALF + wr * 64 + m * 16 + 8 * k + rr, b = row >> 13, p = row & 8191;
                        const int pp = ((p & ((1 << g2) - 1)) << (13 - g2)) + (p >> g2);
                        st16(qkv + ((size_t)((plane * 4 + b) * 8192 + pp) << 6) + 8 * c, k ? o1 : o0); }
                }
        }
    }
};
__device__ __forceinline__ float bflo_(unsigned w) { return __builtin_bit_cast(float, w << 16); }
__device__ __forceinline__ float bfhi_(unsigned w) { return __builtin_bit_cast(float, w & 0xffff0000u); }
__device__ __forceinline__ void unstage16(PG8_LAS unsigned char* stg, int fr, int fq, const u32x4 l0, const u32x4 l1, u32x4& b0, u32x4& b1) {
    const int lane = fr + 16 * fq, rr = lane >> 3, c = lane & 7, x = fr & 7;
    *(PG8_LAS u32x4*)(stg + rr * 128 + ((c ^ rr) << 4)) = l0; *(PG8_LAS u32x4*)(stg + (rr + 8) * 128 + ((c ^ rr) << 4)) = l1;
    b0 = *(const PG8_LAS u32x4*)(stg + fr * 128 + ((fq ^ x) << 4)); b1 = *(const PG8_LAS u32x4*)(stg + fr * 128 + (((4 + fq) ^ x) << 4));
}
struct EpiRes {
    static constexpr bool WCOLS64 = true, PERM = true, AFTER_DRAIN = false, IDEMP = false;
    bf16_t* xb; float* stats; PG8_LAS unsigned char* stg0;
    __device__ __forceinline__ void operator()(const f32x4 (&acc)[2][2][4][2], const Unit& u, int wr, int wc, int fr, int fq) const {
        PG8_LAS unsigned char* stg = stg0 + (wr * 4 + wc) * 2048; const int lane = fr + 16 * fq, rr = lane >> 3, c = lane & 7;
        bf16_t* xw = xb + (size_t)(u.pm * BM + wr * 64 + rr) * 1024 + u.pn * BM + wc * 64 + 8 * c;
        const int row0 = u.pm * BM + wr * 64 + fr;
#pragma unroll
        for (int ai = 0; ai < 2; ++ai)
#pragma unroll
            for (int m = 0; m < 4; ++m) {
                bf16_t* p0 = xw + (size_t)(ai * HALF + m * 16) * 1024; bf16_t* p1 = p0 + 8 * 1024;
                const u32x4 l0 = *(const u32x4*)p0, l1 = *(const u32x4*)p1; u32x4 bq[2];
                unstage16(stg, fr, fq, l0, l1, bq[0], bq[1]);
                float ss = 0.f; u32x4 pk[2];
#pragma unroll
                for (int bj = 0; bj < 2; ++bj) { const u32x4 b = bq[bj];
                    const f32x4 o0 = (f32x4){bflo_(b.x), bfhi_(b.x), bflo_(b.y), bfhi_(b.y)} + acc[ai][bj][m][0] * KSC, o1 = (f32x4){bflo_(b.z), bfhi_(b.z), bflo_(b.w), bfhi_(b.w)} + acc[ai][bj][m][1] * KSC;
                    ss += (o0[0] * o0[0] + o0[1] * o0[1]) + (o0[2] * o0[2] + o0[3] * o0[3]) + (o1[0] * o1[0] + o1[1] * o1[1]) + (o1[2] * o1[2] + o1[3] * o1[3]);
                    pk[bj] = pack8(o0, o1); }
                u32x4 r0, r1; stage16(stg, fr, fq, pk[0], pk[1], r0, r1);
                st16(p0, r0); st16(p1, r1);
                ss += __shfl_xor(ss, 16); ss += __shfl_xor(ss, 32);
                if (fq == 0) stats[(size_t)(row0 + ai * HALF + m * 16) * 16 + u.pn * 4 + wc] = ss;
            }
    }
};
struct EpiFinal {
    static constexpr bool WCOLS64 = false, PERM = true, AFTER_DRAIN = false, IDEMP = false;
    const bf16_t* xb; float* out; const float* gain; float* xslot; unsigned* cnt; unsigned* tmo; PG8_LAS unsigned char* lx;
    __device__ __forceinline__ void operator()(f32x4 (&acc)[2][2][4][2], const Unit& u, int wr, int wc, int fr, int fq) const {
        const int tid = threadIdx.x, lane = tid & 63, wid = __builtin_amdgcn_readfirstlane(tid >> 6);
        PG8_LAS float* P = (PG8_LAS float*)lx; PG8_LAS float* S = (PG8_LAS float*)(lx + 4096); PG8_LAS unsigned* flag = (PG8_LAS unsigned*)(lx + 5120);
        const int rl0 = wr * 64 + fr, col0 = u.pn * BM + wc * 32 + 8 * fq;
#pragma unroll
        for (int ai = 0; ai < 2; ++ai)
#pragma unroll
            for (int m = 0; m < 4; ++m) {
                const int rl = rl0 + ai * HALF + m * 16; const size_t off = (size_t)(u.pm * BM + rl) * 1024 + col0; float ss = 0.f;
#pragma unroll
                for (int bj = 0; bj < 2; ++bj) {
                    const u32x4 b = *(const u32x4*)(xb + off + bj * HALF);
                    const f32x4 o0 = (f32x4){bflo_(b.x), bfhi_(b.x), bflo_(b.y), bfhi_(b.y)} + acc[ai][bj][m][0] * KSC, o1 = (f32x4){bflo_(b.z), bfhi_(b.z), bflo_(b.w), bfhi_(b.w)} + acc[ai][bj][m][1] * KSC;
                    ss += (o0[0] * o0[0] + o0[1] * o0[1]) + (o0[2] * o0[2] + o0[3] * o0[3]) + (o1[0] * o1[0] + o1[1] * o1[1]) + (o1[2] * o1[2] + o1[3] * o1[3]);
                    acc[ai][bj][m][0] = o0; acc[ai][bj][m][1] = o1;
                }
                ss += __shfl_xor(ss, 16); ss += __shfl_xor(ss, 32);
                if (fq == 0) P[rl * 4 + wc] = ss;
            }
        asm volatile("s_waitcnt lgkmcnt(0)" ::: "memory"); __builtin_amdgcn_s_barrier(); asm volatile("" ::: "memory");
        if (tid < 256) { const f32x4 p = *(const PG8_LAS f32x4*)(P + tid * 4);
            __hip_atomic_store(xslot + (size_t)(u.pm * BM + tid) * 4 + u.pn, (p[0] + p[1]) + (p[2] + p[3]), __ATOMIC_RELAXED, __HIP_MEMORY_SCOPE_AGENT); }
        asm volatile("s_waitcnt vmcnt(0)" ::: "memory");
        if (tid < 256 && lane == 0) __hip_atomic_fetch_add(cnt + 64 * u.pm, 1u, __ATOMIC_RELAXED, __HIP_MEMORY_SCOPE_AGENT);
        if (wid == 0) {
            bool dead = false; const unsigned long long t0 = __builtin_amdgcn_s_memrealtime();
            for (;;) {
                if ((unsigned)__builtin_amdgcn_readfirstlane(__hip_atomic_load(cnt + 64 * u.pm, __ATOMIC_RELAXED, __HIP_MEMORY_SCOPE_AGENT)) >= 16u) break;
                if (__builtin_amdgcn_s_memrealtime() - t0 > 2000000ull) { if (lane == 0) __hip_atomic_store(tmo, 1u, __ATOMIC_RELAXED, __HIP_MEMORY_SCOPE_AGENT); dead = true; break; }
                __builtin_amdgcn_s_sleep(2);
            }
            __builtin_amdgcn_fence(__ATOMIC_ACQUIRE, "agent");
            if (lane == 0) flag[0] = dead ? 1u : 0u;
        }
        asm volatile("s_waitcnt vmcnt(0) lgkmcnt(0)" ::: "memory"); __builtin_amdgcn_s_barrier(); asm volatile("" ::: "memory");
        if (tid < 256) { const float* sl = xslot + (size_t)(u.pm * BM + tid) * 4; float q = 0.f;
#pragma unroll
            for (int t = 0; t < 4; ++t) q += __hip_atomic_load(sl + t, __ATOMIC_RELAXED, __HIP_MEMORY_SCOPE_AGENT);
            S[tid] = __builtin_amdgcn_rsqf(q * (1.0f / 1024.0f) + 1e-6f); }
        asm volatile("s_waitcnt lgkmcnt(0)" ::: "memory"); __builtin_amdgcn_s_barrier(); asm volatile("" ::: "memory");
        f32x4 gv[2][2];
#pragma unroll
        for (int bj = 0; bj < 2; ++bj) { gv[bj][0] = *(const f32x4*)(gain + col0 + bj * HALF); gv[bj][1] = *(const f32x4*)(gain + col0 + bj * HALF + 4); }
#pragma unroll
        for (int ai = 0; ai < 2; ++ai)
#pragma unroll
            for (int m = 0; m < 4; ++m) {
                const int rl = rl0 + ai * HALF + m * 16; const float rstd = S[rl]; float* op = out + (size_t)(u.pm * BM + rl) * 1024 + col0;
#pragma unroll
                for (int bj = 0; bj < 2; ++bj) { *(f32x4*)(op + bj * HALF) = acc[ai][bj][m][0] * rstd * gv[bj][0]; *(f32x4*)(op + bj * HALF + 4) = acc[ai][bj][m][1] * rstd * gv[bj][1]; }
            }
    }
};
struct EpiUp {
    static constexpr bool WCOLS64 = true, PERM = true, AFTER_DRAIN = false, IDEMP = false;
    bf16_t* z; const PG8_LAS float* rstab; PG8_LAS unsigned char* stg0;
    __device__ __forceinline__ void operator()(const f32x4 (&acc)[2][2][4][2], const Unit& u, int wr, int wc, int fr, int fq) const {
        float rs[2][4]; row_rstd(rstab, u, wr, fr, rs);
        PG8_LAS unsigned char* stg = stg0 + (wr * 4 + wc) * 2048; const int lane = fr + 16 * fq, rr = lane >> 3, c = lane & 7;
        bf16_t* zb = z + (size_t)(u.pm * BM + wr * 64 + rr) * 4096 + u.pn * BM + wc * 64 + 8 * c;
#pragma unroll
        for (int ai = 0; ai < 2; ++ai)
#pragma unroll
            for (int m = 0; m < 4; ++m) {
                const float r = rs[ai][m]; u32x4 pk[2];
#pragma unroll
                for (int bj = 0; bj < 2; ++bj) {
                    f32x4 a = acc[ai][bj][m][0] * r, b = acc[ai][bj][m][1] * r;
#pragma unroll
                    for (int j = 0; j < 4; ++j) { const float x = fmaxf(a[j], 0.f), y = fmaxf(b[j], 0.f); a[j] = x * x; b[j] = y * y; }
                    pk[bj] = pack8(a, b);
                }
                u32x4 o0, o1; stage16(stg, fr, fq, pk[0], pk[1], o0, o1);
                st16(zb + (size_t)(ai * HALF + m * 16) * 4096, o0); st16(zb + (size_t)(ai * HALF + m * 16 + 8) * 4096, o1);
            }
    }
};
struct EpiIn1 {
    static constexpr bool WCOLS64 = true, PERM = true, AFTER_DRAIN = false, IDEMP = false;
    bf16_t* cv; bf16_t* bg; const PG8_LAS float* rstab; PG8_LAS unsigned char* stg0;
    __device__ __forceinline__ void operator()(const f32x4 (&acc)[2][2][4][2], const Unit& u, int wr, int wc, int fr, int fq) const {
        const int row0 = u.pm * BM + wr * 64 + fr;
        float rs[2][4]; row_rstd(rstab, u, wr, fr, rs);
        if (u.pn < 8) {
            const int col0 = u.pn * 128 + wc * 32 + 8 * fq;
#pragma unroll
            for (int ai = 0; ai < 2; ++ai)
#pragma unroll
                for (int m = 0; m < 4; ++m) {
                    const float r2 = rs[ai][m] * rs[ai][m];
                    st16(cv + (size_t)(row0 + ai * HALF + m * 16) * 1024 + col0, pack8(acc[ai][0][m][0] * acc[ai][1][m][0] * r2, acc[ai][0][m][1] * acc[ai][1][m][1] * r2));
                }
        } else {
            PG8_LAS unsigned char* stg = stg0 + (wr * 4 + wc) * 2048; const int lane = fr + 16 * fq, rr = lane >> 3, c = lane & 7;
            bf16_t* bb = bg + (size_t)(u.pm * BM + wr * 64 + rr) * 1024 + (u.pn - 8) * BM + wc * 64 + 8 * c;
#pragma unroll
            for (int ai = 0; ai < 2; ++ai)
#pragma unroll
                for (int m = 0; m < 4; ++m) {
                    const float r = rs[ai][m]; u32x4 o0, o1;
                    stage16(stg, fr, fq, pack8(acc[ai][0][m][0] * r, acc[ai][0][m][1] * r), pack8(acc[ai][1][m][0] * r, acc[ai][1][m][1] * r), o0, o1);
                    st16(bb + (size_t)(ai * HALF + m * 16) * 1024, o0); st16(bb + (size_t)(ai * HALF + m * 16 + 8) * 1024, o1);
                }
        }
    }
};
template <class Epi, class Sched, bool ALIGN_EPI = false, bool SP2 = false>
__device__ __forceinline__ void gemm_phase(PG8_LAS unsigned char* lds, const Gemm g, const Sched& S, const Epi& E) {
    const int tid = threadIdx.x, wid = __builtin_amdgcn_readfirstlane(tid >> 6), lane = tid & 63, wr = wid >> 2, wc = wid & 3, fr = lane & 15, fq = lane >> 4;
    const int K = g.K, nt = K / BK;
    unsigned voffA[2], voffB[2];
#pragma unroll
    for (int i = 0; i < 2; ++i) { int R, C; stage_rc(tid * 16 + i * 8192, R, C); const int r31_ = Epi::PERM ? perm32(R & 31) : (R & 31); const int Rb = (Epi::WCOLS64 ? 64 : 32) * (R >> 5) + r31_;
        voffA[i] = (unsigned)(R * K + C) * 2u; voffB[i] = (unsigned)(Rb * K + C) * 2u; }
    const size_t kstep = (size_t)(BK * 2);
    const size_t hstep = (size_t)HALF * K * 2;
    const size_t tstep = 2 * hstep;
    const size_t hstepB = Epi::WCOLS64 ? (size_t)32 * K * 2 : hstep;
    const unsigned ldsw = (unsigned)wid * 1024u;
    const int aoff = lds_byte(wr * 64 + fr, fq * 8), boff = lds_byte(wc * 32 + fr, fq * 8);
#define PG8_SA(b, h) (((b) * 2 + (h)) * HTB)
#define PG8_SB(b, h) ((4 + (b) * 2 + (h)) * HTB)
#define PG8_STAGE(bufoff, gbase, voff) do { _Pragma("unroll") for (int _i = 0; _i < 2; ++_i) \
        __builtin_amdgcn_global_load_lds((const unsigned*)((const char*)(gbase) + (voff)[_i]), (PG8_LAS unsigned*)(lds + (bufoff) + ldsw + _i * 8192), 16, 0, 0); } while (0)
#define PG8_LDA(dst, b, h) do { _Pragma("unroll") for (int m = 0; m < 4; ++m) _Pragma("unroll") for (int k = 0; k < 2; ++k) dst[m][k] = *(const PG8_LAS bf16x8*)(lds + PG8_SA(b, h) + aoff + m * 2048 + k * 1024); } while (0)
#define PG8_LDB(dst, b, h) do { _Pragma("unroll") for (int n = 0; n < 2; ++n) _Pragma("unroll") for (int k = 0; k < 2; ++k) dst[n][k] = *(const PG8_LAS bf16x8*)(lds + PG8_SB(b, h) + boff + n * 2048 + k * 1024); } while (0)
#if defined(PROBE_MMA2)
#define PG8_MMA_AGAIN(ai, bj, At, Bt) _Pragma("unroll") for (int m = 0; m < 4; ++m) _Pragma("unroll") for (int n = 0; n < 2; ++n) _Pragma("unroll") for (int k = 0; k < 2; ++k) \
        acc[ai][bj][m][n] = __builtin_amdgcn_mfma_f32_16x16x32_bf16(Bt[n][k], At[m][k], acc[ai][bj][m][n], 0, 0, 0);
#else
#define PG8_MMA_AGAIN(ai, bj, At, Bt)
#endif
#define PG8_MMA(ai, bj, At, Bt) do { __builtin_amdgcn_s_setprio(1); _Pragma("unroll") for (int m = 0; m < 4; ++m) _Pragma("unroll") for (int n = 0; n < 2; ++n) _Pragma("unroll") for (int k = 0; k < 2; ++k) \
        acc[ai][bj][m][n] = __builtin_amdgcn_mfma_f32_16x16x32_bf16(Bt[n][k], At[m][k], acc[ai][bj][m][n], 0, 0, 0); PG8_MMA_AGAIN(ai, bj, At, Bt) __builtin_amdgcn_s_setprio(0); } while (0)
#define PG8_WAIT_V(n) asm volatile("s_waitcnt vmcnt(" #n ")" ::: "memory")
#define PG8_WAIT_L(n) asm volatile("s_waitcnt lgkmcnt(" #n ")" ::: "memory")
#define PG8_BAR __builtin_amdgcn_s_barrier()
#define PG8_SCHED __builtin_amdgcn_sched_barrier(0)
    Unit cur, nxt; int ui = 0;
    if (!S.next(0, cur)) return;
    f32x4 acc[2][2][4][2];
#pragma unroll
    for (int a = 0; a < 2; ++a)
#pragma unroll
        for (int b = 0; b < 2; ++b)
#pragma unroll
            for (int m = 0; m < 4; ++m)
#pragma unroll
                for (int n = 0; n < 2; ++n) acc[a][b][m][n] = (f32x4){0.f, 0.f, 0.f, 0.f};
    bf16x8 At[4][2], B0[2][2], B1[2][2];
    const char* cA = (const char*)g.A + (size_t)cur.pm * tstep; const char* cB = (const char*)g.Bt + (size_t)cur.pn * tstep;
    S.a_ready(cur);
    if constexpr (SP2) {
        PG8_STAGE(PG8_SB(0, 0), cB, voffB); PG8_STAGE(PG8_SB(0, 1), cB + hstepB, voffB); PG8_STAGE(PG8_SA(0, 0), cA, voffA); PG8_STAGE(PG8_SA(0, 1), cA + hstep, voffA);
        if (wr == 1) PG8_BAR;
        PG8_WAIT_V(2); PG8_BAR;
        PG8_STAGE(PG8_SB(1, 0), cB + kstep, voffB); PG8_STAGE(PG8_SA(1, 0), cA + kstep, voffA); PG8_STAGE(PG8_SB(1, 1), cB + hstepB + kstep, voffB);
        PG8_WAIT_V(6); PG8_BAR;
    } else {
        PG8_STAGE(PG8_SB(0, 0), cB, voffB); PG8_STAGE(PG8_SA(0, 0), cA, voffA); PG8_STAGE(PG8_SB(0, 1), cB + hstepB, voffB); PG8_STAGE(PG8_SA(0, 1), cA + hstep, voffA);
        if (wr == 1) PG8_BAR;
        PG8_WAIT_V(4); PG8_BAR;
        PG8_STAGE(PG8_SB(1, 0), cB + kstep, voffB); PG8_STAGE(PG8_SA(1, 0), cA + kstep, voffA); PG8_STAGE(PG8_SB(1, 1), cB + hstepB + kstep, voffB);
        PG8_WAIT_V(6); PG8_BAR;
    }
    for (;;) {
        const bool has_next = S.next(ui + 1, nxt);
        const char* nA = has_next ? (const char*)g.A + (size_t)nxt.pm * tstep : cA; const char* nB = has_next ? (const char*)g.Bt + (size_t)nxt.pn * tstep : cB;
#if !defined(PROBE_KREP)
#define PROBE_KREP 1
#endif
#if defined(PROBE_MMA2)
#define PROBE_KLOOP_REP 1
#else
#define PROBE_KLOOP_REP PROBE_KREP
#endif
        for (int tt_ = 0; tt_ < nt * PROBE_KLOOP_REP; tt_ += 2) {
            const int t = tt_ & (nt - 1), t2 = (tt_ + 2) & (nt - 1);
            const bool last = (tt_ == nt * PROBE_KLOOP_REP - 2);
            const char* a1 = cA + (size_t)(t + 1) * kstep;
            const char* a2 = last ? nA : cA + (size_t)t2 * kstep; const char* b2 = last ? nB : cB + (size_t)t2 * kstep;
            const char* a3 = a2 + kstep; const char* b3 = b2 + kstep;
            if (last && has_next) S.a_ready(nxt);
            if constexpr (SP2) {
            PG8_LDB(B0, 0, 0); PG8_LDB(B1, 0, 1); PG8_SCHED; PG8_LDA(At, 0, 0); PG8_STAGE(PG8_SA(1, 1), a1 + hstep, voffA);
            PG8_WAIT_V(8); PG8_WAIT_L(0); PG8_BAR; PG8_MMA(0, 0, At, B0); PG8_MMA(0, 1, At, B1); PG8_BAR; PG8_SCHED;
            PG8_LDA(At, 0, 1); PG8_STAGE(PG8_SB(0, 0), b2, voffB); PG8_STAGE(PG8_SB(0, 1), b2 + hstepB, voffB); PG8_STAGE(PG8_SA(0, 0), a2, voffA);
            PG8_WAIT_V(8); PG8_WAIT_L(0); PG8_BAR; PG8_MMA(1, 0, At, B0); PG8_MMA(1, 1, At, B1); PG8_BAR; PG8_SCHED;
            PG8_LDB(B0, 1, 0); PG8_LDB(B1, 1, 1); PG8_SCHED; PG8_LDA(At, 1, 0); PG8_STAGE(PG8_SA(0, 1), a2 + hstep, voffA);
            PG8_WAIT_V(8); PG8_WAIT_L(0); PG8_BAR; PG8_MMA(0, 0, At, B0); PG8_MMA(0, 1, At, B1); PG8_BAR; PG8_SCHED;
            PG8_LDA(At, 1, 1); PG8_STAGE(PG8_SB(1, 0), b3, voffB); PG8_STAGE(PG8_SB(1, 1), b3 + hstepB, voffB); PG8_STAGE(PG8_SA(1, 0), a3, voffA);
            PG8_WAIT_V(8); PG8_WAIT_L(0); PG8_BAR; PG8_MMA(1, 0, At, B0); PG8_MMA(1, 1, At, B1); PG8_BAR; PG8_SCHED;
            } else {
            PG8_LDB(B0, 0, 0); PG8_SCHED; PG8_LDA(At, 0, 0); PG8_STAGE(PG8_SA(1, 1), a1 + hstep, voffA);
            PG8_WAIT_L(8); PG8_BAR; PG8_WAIT_L(0); PG8_MMA(0, 0, At, B0); PG8_BAR; PG8_SCHED;
            PG8_LDB(B1, 0, 1); PG8_STAGE(PG8_SB(0, 0), b2, voffB);
            PG8_BAR; PG8_WAIT_L(0); PG8_MMA(0, 1, At, B1); PG8_BAR;
            PG8_LDA(At, 0, 1); PG8_STAGE(PG8_SA(0, 0), a2, voffA);
            PG8_BAR; PG8_WAIT_L(0); PG8_MMA(1, 0, At, B0); PG8_BAR; PG8_SCHED;
            PG8_STAGE(PG8_SB(0, 1), b2 + hstepB, voffB);
            PG8_WAIT_V(6); PG8_BAR; PG8_MMA(1, 1, At, B1); PG8_BAR;
            PG8_LDB(B0, 1, 0); PG8_SCHED; PG8_LDA(At, 1, 0); PG8_STAGE(PG8_SA(0, 1), a2 + hstep, voffA);
            PG8_WAIT_L(8); PG8_BAR; PG8_WAIT_L(0); PG8_MMA(0, 0, At, B0); PG8_BAR; PG8_SCHED;
            PG8_LDB(B1, 1, 1); PG8_STAGE(PG8_SB(1, 0), b3, voffB);
            PG8_BAR; PG8_WAIT_L(0); PG8_MMA(0, 1, At, B1); PG8_BAR;
            PG8_LDA(At, 1, 1); PG8_STAGE(PG8_SA(1, 0), a3, voffA);
            PG8_BAR; PG8_WAIT_L(0); PG8_MMA(1, 0, At, B0); PG8_BAR; PG8_SCHED;
            PG8_STAGE(PG8_SB(1, 1), b3 + hstepB, voffB);
            PG8_WAIT_V(6); PG8_BAR; PG8_MMA(1, 1, At, B1); PG8_BAR;
            }
        }
        if constexpr (ALIGN_EPI) { if (wr == 0) PG8_BAR; }
        if constexpr (!Epi::AFTER_DRAIN) { E(acc, cur, wr, wc, fr, fq);
#if defined(PROBE_EPI2)
            if constexpr (Epi::IDEMP) { asm volatile("" ::: "memory"); E.probe(acc, cur, wr, wc, fr, fq); }
#endif
            S.done(cur); }
        if (!has_next) break;
#pragma unroll
        for (int a = 0; a < 2; ++a)
#pragma unroll
            for (int b = 0; b < 2; ++b)
#pragma unroll
                for (int m = 0; m < 4; ++m)
#pragma unroll
                    for (int n = 0; n < 2; ++n) acc[a][b][m][n] = (f32x4){0.f, 0.f, 0.f, 0.f};
        cur = nxt; cA = nA; cB = nB; ++ui;
        if constexpr (ALIGN_EPI) { if (wr == 1) PG8_BAR; }
    }
    PG8_WAIT_V(0);
    if constexpr (!ALIGN_EPI) { if (wr == 0) PG8_BAR; }
    PG8_BAR;
    if constexpr (Epi::AFTER_DRAIN) { E.fused(acc, cur, wr, wc, fr, fq, lds, wid, lane); S.done(cur); }
#undef PG8_SA
#undef PG8_SB
#undef PG8_STAGE
#undef PG8_LDA
#undef PG8_LDB
#undef PG8_MMA
#undef PG8_WAIT_V
#undef PG8_WAIT_L
#undef PG8_BAR
#undef PG8_SCHED
}
}
#ifndef PG8_SP2
#define PG8_SP2 true
#endif
#ifndef PG8_ALIGN
#define PG8_ALIGN true
#endif
constexpr int CW_BAR = 4096;
constexpr int CW_TMO = 0, CW_SEAM = 16384;
#define GAS __attribute__((address_space(1)))
#define LAS __attribute__((address_space(3)))
typedef unsigned short bf16;
typedef unsigned v4u __attribute__((ext_vector_type(4)));
typedef float f32x4 __attribute__((ext_vector_type(4)));
typedef short bf16x8 __attribute__((ext_vector_type(8)));
typedef GAS unsigned gu32;
typedef GAS unsigned long long gu64;
#define RLX_AGENT __ATOMIC_RELAXED, __HIP_MEMORY_SCOPE_AGENT
#define LDS_WAIT() asm volatile("s_waitcnt lgkmcnt(0)" ::: "memory")
#define VM_WAIT() asm volatile("s_waitcnt vmcnt(0)" ::: "memory")
__device__ __forceinline__ unsigned long long rt() { return __builtin_amdgcn_s_memrealtime(); }
__device__ __forceinline__ unsigned f2bf(float f) { unsigned u = __builtin_bit_cast(unsigned, f); return (u + 0x7fffu + ((u >> 16) & 1u)) >> 16; }
__device__ __forceinline__ unsigned pk2(float lo, float hi) { return f2bf(lo) | (f2bf(hi) << 16); }

#define XB_TMO      128
#define XB_XCNT(j)  (256  + 64 * (j))
#define XB_XSUB(j)  (1280 + 64 * (j))
#define XB_XGEN(j)  (2304 + 64 * (j))
#define XB_TOP      3328
#define XB_TOPGEN   3392
#define XCD_BAR_WORDS 3456
#define XB_SPIN_CAP (1u << 18)

__device__ __forceinline__ unsigned xb_ld(unsigned* p)              { return __hip_atomic_load(p, __ATOMIC_RELAXED, __HIP_MEMORY_SCOPE_AGENT); }
__device__ __forceinline__ unsigned xb_add(unsigned* p, unsigned v) { return __hip_atomic_fetch_add(p, v, __ATOMIC_RELAXED, __HIP_MEMORY_SCOPE_AGENT); }
__device__ __forceinline__ unsigned xb_xcc_id() { return (unsigned)__builtin_amdgcn_s_getreg((3 << 11) | 20) & 0xFu; }
#define XB_SPIN(cond, bar) do { unsigned _sp = 0; while (cond) { __builtin_amdgcn_s_sleep(1); \
    if ((++_sp & 255u) == 0u) { if (xb_ld(&(bar)[XB_TMO])) break; if (_sp > XB_SPIN_CAP) { atomicAdd(&(bar)[XB_TMO], 1u); break; } } } } while (0)

struct XcdBarrier {
    unsigned* bar; unsigned x;
    volatile LAS unsigned* st;
};

__device__ __forceinline__ XcdBarrier xcd_barrier_post(unsigned* bar, volatile LAS unsigned* st) {
    XcdBarrier b; b.bar = bar; b.x = xb_xcc_id(); b.st = st;
    if (threadIdx.x == 0) (void)xb_add(&bar[XB_XCNT(b.x)], 1u);
    return b;
}
__device__ __forceinline__ void xcd_barrier_complete(unsigned* bar, unsigned x, unsigned& nloc, unsigned& nx) {
    const unsigned G = gridDim.x * gridDim.y * gridDim.z;
    unsigned sum, cnt, mine, sp = 0u;
    for (;;) {
        sum = 0u; cnt = 0u; mine = 0u;
#pragma unroll
        for (unsigned j = 0; j < 16; ++j) { const unsigned c = xb_ld(&bar[XB_XCNT(j)]); sum += c; cnt += (c > 0u) ? 1u : 0u; mine = (j == x) ? c : mine; }
        if (sum == G) break;
        __builtin_amdgcn_s_sleep(1);
        if ((++sp & 255u) == 0u) { if (xb_ld(&bar[XB_TMO])) break; if (sp > XB_SPIN_CAP) { atomicAdd(&bar[XB_TMO], 1u); break; } }
    }
    nloc = mine > 0u ? mine : 1u; nx = cnt > 0u ? cnt : 1u;
}

__device__ __forceinline__ void xcd_barrier(const XcdBarrier& b) {
    asm volatile("s_waitcnt vmcnt(0)" ::: "memory");
    __syncthreads();
    if (threadIdx.x == 0) {
        unsigned* bar = b.bar;
        __builtin_amdgcn_s_waitcnt(0);
        unsigned nloc = b.st[0], nx = b.st[1];
        if (nloc == 0u) { xcd_barrier_complete(bar, b.x, nloc, nx); b.st[0] = nloc; b.st[1] = nx; }
        const unsigned old = xb_add(&bar[XB_XSUB(b.x)], 1u);
        const unsigned gen = old / nloc;
        if (old + 1u == (gen + 1u) * nloc) {
            __builtin_amdgcn_fence(__ATOMIC_RELEASE, "agent");
            asm volatile("s_waitcnt vmcnt(0)" ::: "memory");
            const unsigned og = xb_add(&bar[XB_TOP], 1u);
            const unsigned tg = og / nx;
            if (og + 1u == (tg + 1u) * nx) xb_add(&bar[XB_TOPGEN], 1u);
            else XB_SPIN(xb_ld(&bar[XB_TOPGEN]) == tg, bar);
            __builtin_amdgcn_fence(__ATOMIC_ACQUIRE, "agent");
            xb_add(&bar[XB_XGEN(b.x)], 1u);
            asm volatile("s_waitcnt vmcnt(0)" ::: "memory");
        } else {
            XB_SPIN(xb_ld(&bar[XB_XGEN(b.x)]) == gen, bar);
            __builtin_amdgcn_fence(__ATOMIC_ACQUIRE, "agent");
            asm volatile("s_waitcnt vmcnt(0)" ::: "memory");
        }
    }
    __syncthreads();
}

constexpr int NWAVES = 8;
#ifndef MK_N_LAUNCHES
#define MK_N_LAUNCHES 1
#endif
#ifndef FUSE_FINAL
#define FUSE_FINAL 0
#endif
constexpr int N_PHASES = FUSE_FINAL ? 12 : 13;
#ifndef PROBE_MASK
#define PROBE_MASK 0
#endif
#define REPS(k) for (int rep_ = 0; rep_ < (((PROBE_MASK) >> (k)) & 1) + 1; ++rep_)
constexpr int N_LAUNCHES = MK_N_LAUNCHES;

constexpr int BATCH = 4, SEQ = 8192, D = 1024, M = BATCH * SEQ, FF = 4096, N_IN0 = 5632, N_IN1 = 3072, NQKV = 4608, CA = 512, CONVW = 31;
constexpr float LOG2E = 1.4426950408889634f, QSCALE = 0.125f * LOG2E, RMS_EPS = 1e-6f, LN_EPS = 1e-5f;

constexpr size_t MiB = 1u << 20;
constexpr size_t WS_CTL = 0, CTL_ZERO_BYTES = 1 * MiB;
constexpr size_t WS_STATS = 1 * MiB;
constexpr size_t WS_BIAS2 = 3 * MiB;
constexpr size_t WS_LSE = 4 * MiB;
constexpr size_t WS_W_IN0 = 8 * MiB, WS_W_OUT0 = 19 * MiB, WS_W_UP0 = 21 * MiB, WS_W_DN0 = 29 * MiB, WS_W_IN1 = 37 * MiB, WS_W_OUT1 = 43 * MiB, WS_W_UP1 = 45 * MiB, WS_W_DN1 = 53 * MiB;
constexpr size_t WS_XB = 64 * MiB;
constexpr size_t WS_R2 = 128 * MiB;
constexpr size_t WS_END = 416 * MiB;
constexpr size_t OUT_OG = 0, OUT_HGLU = 96 * MiB;

constexpr int RING_OFF = 0, RING_BYTES = 131072;
constexpr int AT_K = 0, AT_V = 49152, AT_BT = 98304, AT_WS = 118784, AT_OST = 120832, AT_END = 153600;
constexpr int RSTAB_OFF = RING_BYTES, ESTG_OFF = RING_BYTES + 11264;
constexpr int LDSCTL_OFF = 162816, MISC_OFF = LDSCTL_OFF + 320;
constexpr int LDS_BYTES = 163840;
static_assert(ESTG_OFF + 16384 <= LDSCTL_OFF && AT_END <= LDSCTL_OFF, "LDS map");

struct Frame {
    LAS unsigned char* lds;
    volatile LAS unsigned* MISC;
    gu32* ctl;
    int tid, lane, wave;
    int vcu, G;
};
struct Args { const float* in[17]; float* out; unsigned char* ws; int ph_lo, ph_hi, li, pad; };

__device__ __forceinline__ float wave_sum(float v) {
#pragma unroll
    for (int o = 1; o < 64; o <<= 1) v += __shfl_xor(v, o);
    return v;
}
__device__ __forceinline__ float bf2f(unsigned short b) { return __builtin_bit_cast(float, (unsigned)b << 16); }
__device__ __forceinline__ float bflo(unsigned w) { return __builtin_bit_cast(float, w << 16); }
__device__ __forceinline__ float bfhi(unsigned w) { return __builtin_bit_cast(float, w & 0xffff0000u); }

__device__ __forceinline__ int colmap(int mode, int n0) {
    if (mode == 1) { if (n0 < 512) return 256 * (n0 >> 7) + 64 * ((n0 & 127) >> 5) + (n0 & 31); if (n0 < 1024) { const int c = n0 - 512; return 256 * (c >> 7) + 64 * ((c & 127) >> 5) + 32 + (c & 31); } return n0; }
    if (mode == 2) { if (n0 < 1024) return 2048 + n0; if (n0 < 2048) { const int c = n0 - 1024; return 256 * (c >> 7) + 64 * ((c & 127) >> 5) + (c & 31); } const int v = n0 - 2048; return 256 * (v >> 7) + 64 * ((v & 127) >> 5) + 32 + (v & 31); }
    return n0;
}
__device__ __forceinline__ void p0_transpose_item(const float* W, int K, int N, bf16* WT, const float* gain, int mode, LAS float* scr, int item, int lane) {
    const int nblk = N / 64, kb = item / nblk, nb = item % nblk, k0 = 64 * kb, n0 = 64 * nb;
    const int lk = lane >> 4, n4 = 4 * (lane & 15);
#pragma unroll 4
    for (int i = 0; i < 16; ++i) { const int kk = 4 * i + lk; const float g = gain ? gain[k0 + kk] : 1.0f; const f32x4 v = *(const GAS f32x4*)(W + (size_t)(k0 + kk) * N + n0 + n4);
        LAS float* d = scr + kk * 65 + n4; d[0] = g * v.x; d[1] = g * v.y; d[2] = g * v.z; d[3] = g * v.w; }
    LDS_WAIT(); asm volatile("" ::: "memory");
    const int c = lane & 7;
#pragma unroll
    for (int j = 0; j < 8; ++j) { const int n = (lane >> 3) + 8 * j; const LAS float* s = scr + (8 * c) * 65 + n;
        v4u o; o.x = pk2(s[0 * 65], s[1 * 65]); o.y = pk2(s[2 * 65], s[3 * 65]); o.z = pk2(s[4 * 65], s[5 * 65]); o.w = pk2(s[6 * 65], s[7 * 65]);
        *(GAS v4u*)(WT + (size_t)(colmap(mode, n0 + (n & 32)) + (n & 31)) * K + k0 + 8 * c) = o; }
    LDS_WAIT(); asm volatile("" ::: "memory");
}
__device__ __forceinline__ void p0_x_item(const float* x, bf16* xb, float* stats, int item, int lane) {
#pragma unroll
    for (int rr = 0; rr < 4; ++rr) { const int m = 4 * item + rr; float s = 0.f;
#pragma unroll
        for (int hh = 0; hh < 2; ++hh) { const float* p = x + (size_t)m * D + 512 * hh + 8 * lane; const f32x4 a = *(const GAS f32x4*)p, b = *(const GAS f32x4*)(p + 4);
            s += (a.x * a.x + a.y * a.y) + (a.z * a.z + a.w * a.w) + (b.x * b.x + b.y * b.y) + (b.z * b.z + b.w * b.w);
            v4u o; o.x = pk2(a.x, a.y); o.y = pk2(a.z, a.w); o.z = pk2(b.x, b.y); o.w = pk2(b.z, b.w); *(GAS v4u*)(xb + (size_t)m * D + 512 * hh + 8 * lane) = o; }
        s = wave_sum(s);
        if (lane < 16) stats[(size_t)m * 16 + lane] = lane == 0 ? s : 0.f; }
}
__device__ __forceinline__ void p0_prologue(Frame& F, const Args& a) {
    unsigned char* ws = a.ws;
    LAS float* scr = (LAS float*)(F.lds + RING_OFF + F.wave * 16640);
    const int gw = F.vcu * NWAVES + F.wave, NGW = F.G * NWAVES;
    constexpr int I_IN0 = (D / 64) * (N_IN0 / 64), I_SQ = (D / 64) * (D / 64), I_UP = (D / 64) * (FF / 64), I_DN = (FF / 64) * (D / 64), I_IN1 = (D / 64) * (N_IN1 / 64);
    constexpr int NW_ITEMS = I_IN0 + 2 * I_SQ + 2 * I_UP + 2 * I_DN + I_IN1, NITEMS = NW_ITEMS + M / 4;
    const float* x = a.in[0]; bf16* xb = (bf16*)(ws + WS_XB); float* stats = (float*)(ws + WS_STATS);
    for (int it = gw; it < NITEMS; it += NGW) {
        int r = it;
        if (r >= NW_ITEMS) { p0_x_item(x, xb, stats, r - NW_ITEMS, F.lane); continue; }
        if (r < I_IN0) { p0_transpose_item(a.in[3], D, N_IN0, (bf16*)(ws + WS_W_IN0), a.in[2], 1, scr, r, F.lane); continue; } r -= I_IN0;
        if (r < I_SQ) { p0_transpose_item(a.in[8], D, D, (bf16*)(ws + WS_W_OUT0), nullptr, 0, scr, r, F.lane); continue; } r -= I_SQ;
        if (r < I_UP) { p0_transpose_item(a.in[14], D, FF, (bf16*)(ws + WS_W_UP0), a.in[13], 0, scr, r, F.lane); continue; } r -= I_UP;
        if (r < I_DN) { p0_transpose_item(a.in[15], FF, D, (bf16*)(ws + WS_W_DN0), nullptr, 0, scr, r, F.lane); continue; } r -= I_DN;
        if (r < I_IN1) { p0_transpose_item(a.in[10], D, N_IN1, (bf16*)(ws + WS_W_IN1), a.in[9], 2, scr, r, F.lane); continue; } r -= I_IN1;
        if (r < I_SQ) { p0_transpose_item(a.in[12], D, D, (bf16*)(ws + WS_W_OUT1), nullptr, 0, scr, r, F.lane); continue; } r -= I_SQ;
        if (r < I_UP) { p0_transpose_item(a.in[14] + (size_t)D * FF, D, FF, (bf16*)(ws + WS_W_UP1), a.in[13] + D, 0, scr, r, F.lane); continue; } r -= I_UP;
        p0_transpose_item(a.in[15] + (size_t)FF * D, FF, D, (bf16*)(ws + WS_W_DN1), nullptr, 0, scr, r, F.lane);
    }
    if (blockIdx.x == 0) {
        float* b2 = (float*)(ws + WS_BIAS2); const float* rb = a.in[1];
        for (int i = F.tid; i < 24 * 129; i += NWAVES * 64) {
            const int gh = i / 129, m = i % 129, g = gh >> 3, n = m << (2 * g);
            int bucket = n;
            if (n >= 16) { const float nf = (float)n; const int large = 16 + (int)(logf(nf / 16.0f) / logf(128.0f) * 16.0f); bucket = large < 31 ? large : 31; }
            b2[gh * 132 + m] = LOG2E * rb[bucket * 24 + gh];
        }
    }
}

typedef float f32x16 __attribute__((ext_vector_type(16)));
typedef short s16x4 __attribute__((ext_vector_type(4)));
typedef short v4i16_t __attribute__((ext_vector_type(4)));
__device__ __forceinline__ int crow(int r, int hi) { return (r & 3) + 8 * (r >> 2) + 4 * hi; }
__device__ __forceinline__ s16x4 vtr(const LAS unsigned char* p) { return __builtin_bit_cast(s16x4, __builtin_amdgcn_ds_read_tr16_b64_v4i16((LAS v4i16_t*)p)); }
__device__ __forceinline__ unsigned cvtpk_s(float lo, float hi) { typedef float f2 __attribute__((ext_vector_type(2))); typedef __bf16 b2 __attribute__((ext_vector_type(2))); f2 v = {lo, hi}; b2 b = __builtin_convertvector(v, b2); return __builtin_bit_cast(unsigned, b); }
constexpr int ATT_UNITS = BATCH * 3 * 8 * 32;
__device__ __forceinline__ void glds16(const void* gsrc, unsigned lds_dst) { unsigned keep;
    asm volatile("s_mov_b32 %0, m0\n\ts_mov_b32 m0, %2\n\ts_nop 0\n\tglobal_load_lds_dwordx4 %1, off\n\ts_mov_b32 m0, %0" : "=&s"(keep) : "v"(gsrc), "s"(lds_dst) : "memory"); }
struct AttUnit { const bf16* Qb; const bf16* Kb; const bf16* Vb; size_t rowbase; int g, h, gh, d, j0; };
__device__ __forceinline__ AttUnit att_decode(int u, const bf16* qkv) {
    AttUnit t; const int rb = u & 31, b = u / 768; t.h = (u >> 5) & 7; t.g = (u >> 8) % 3; t.gh = t.g * 8 + t.h;
    t.d = 1 << (2 * t.g); const int lgn = 5 - 2 * t.g, r = rb >> lgn; t.j0 = (rb & ((1 << lgn) - 1)) * 256;
    t.rowbase = (size_t)b * SEQ + r;
    t.Qb = qkv + ((size_t)((t.gh * 4 + b) * 8192 + r * (SEQ >> (2 * t.g))) << 6);
    t.Kb = t.Qb + (size_t)24 * 4 * 8192 * 64; t.Vb = t.Kb + (size_t)24 * 4 * 8192 * 64; return t;
}
__device__ __forceinline__ void att_issue_k(const AttUnit& t, unsigned kl, int wave, int lane) {
#pragma unroll
    for (int k = 0; k < 6; ++k) {
        const int inst = wave * 6 + k, tr = 8 * inst + (lane >> 3); int kj = t.j0 - 128 + tr; kj = kj < 0 ? 0 : kj;
        const int c = (lane & 7) ^ ((tr >> 1) & 7);
        glds16(t.Kb + kj * 64 + c * 8, (unsigned)__builtin_amdgcn_readfirstlane((int)(kl + inst * 1024)));
    }
}
__device__ __forceinline__ void att_issue_v(const AttUnit& t, unsigned vl, int wave, int lane) {
#pragma unroll
    for (int k = 0; k < 6; ++k) {
        const int inst = wave * 6 + k, dh = inst / 24, kg = inst % 24, tr = 16 * kg + (lane >> 2); int kj = t.j0 - 128 + tr; kj = kj < 0 ? 0 : kj;
        glds16(t.Vb + kj * 64 + ((lane & 3) + 4 * dh) * 8, (unsigned)__builtin_amdgcn_readfirstlane((int)(vl + inst * 1024)));
    }
}
__device__ __forceinline__ void p2_attention(Frame& F, const Args& a) {
    const bf16* qkv = (const bf16*)(a.ws + WS_R2); bf16* og = (bf16*)((unsigned char*)a.out + OUT_OG); float* lse = (float*)(a.ws + WS_LSE); const float* b2 = (const float*)(a.ws + WS_BIAS2);
    LAS unsigned char* const KL = F.lds + AT_K; LAS unsigned char* const VL = F.lds + AT_V; LAS float* const BT = (LAS float*)(F.lds + AT_BT);
    LAS float* const wsf = (LAS float*)(F.lds + AT_WS) + F.wave * 64; LAS bf16* const stg = (LAS bf16*)(F.lds + AT_OST) + F.wave * 2048;
    const unsigned kl = (unsigned)(uintptr_t)KL, vl = (unsigned)(uintptr_t)VL;
    const int lane = F.lane, wave = F.wave, r32 = lane & 31, hi = lane >> 5;
    const int upw = (ATT_UNITS + F.G - 1) / F.G, u0 = F.vcu * upw;
    int nu = ATT_UNITS - u0; nu = nu < 0 ? 0 : (nu > upw ? upw : nu);
    if (nu == 0) return;
    int prev_gh = -1;
    const int vlane = ((lane >> 4) & 1) * 32 + (lane & 3) * 8 + (4 * hi + ((lane & 15) >> 2)) * 64;
    AttUnit cur = att_decode(u0, qkv);
    att_issue_k(cur, kl, wave, lane);
    pg8::bf16x8 qn[4];
    { const bf16* qp = cur.Qb + (cur.j0 + 32 * wave + r32) * 64 + hi * 8;
#pragma unroll
      for (int d0 = 0; d0 < 4; ++d0) qn[d0] = *(const pg8::bf16x8*)(qp + d0 * 16); }
    asm volatile("" : "+v"(qn[0]), "+v"(qn[1]), "+v"(qn[2]), "+v"(qn[3]));
    for (int i = 0; i < nu; ++i) {
        const bool has_next = (i + 1 < nu);
        const AttUnit nxt = att_decode(has_next ? u0 + i + 1 : u0 + i, qkv);
        const int g = cur.g, h = cur.h, d = cur.d, j0 = cur.j0; const size_t rowbase = cur.rowbase;
        if (cur.gh != prev_gh) {
            prev_gh = cur.gh;
            for (int e = F.tid; e < 5 * 4 * 64 * 4; e += NWAVES * 64) {
                const int ii = e & 3, L = (e >> 2) & 63, r4 = (e >> 8) & 3, kb = e >> 10, q = L & 31, hh = L >> 5;
                const int m = 128 - 32 * kb + q - (8 * r4 + 4 * hh + ii);
                BT[e] = (m >= 0 && m <= 128) ? b2[cur.gh * 132 + m] : -1e30f;
            }
        }
        asm volatile("s_waitcnt vmcnt(0) lgkmcnt(0)\n\ts_barrier" ::: "memory");
        att_issue_v(cur, vl, wave, lane);
        pg8::bf16x8 qr[4];
#pragma unroll
        for (int d0 = 0; d0 < 4; ++d0) qr[d0] = qn[d0];
        if (has_next) { const bf16* qp = nxt.Qb + (nxt.j0 + 32 * wave + r32) * 64 + hi * 8;
#pragma unroll
            for (int d0 = 0; d0 < 4; ++d0) qn[d0] = *(const pg8::bf16x8*)(qp + d0 * 16); }
        f32x16 S[5];
        const bool first = (j0 == 0);
#pragma unroll
        for (int kb = 0; kb < 5; ++kb) {
            f32x16 acc;
#pragma unroll
            for (int r4 = 0; r4 < 4; ++r4) { const f32x4 t = *(const LAS f32x4*)(BT + ((kb * 4 + r4) * 64 + lane) * 4); acc[4 * r4 + 0] = t[0]; acc[4 * r4 + 1] = t[1]; acc[4 * r4 + 2] = t[2]; acc[4 * r4 + 3] = t[3]; }
            const int trow = 32 * (wave + kb) + r32;
#pragma unroll
            for (int d0 = 0; d0 < 4; ++d0) {
                const pg8::bf16x8 kf = *(const LAS pg8::bf16x8*)(KL + trow * 128 + (((2 * d0 + hi) ^ ((trow >> 1) & 7)) << 4));
                acc = __builtin_amdgcn_mfma_f32_32x32x16_bf16(kf, qr[d0], acc, 0, 0, 0);
            }
            if (first && kb < 4 - wave) {
#pragma unroll
                for (int rr = 0; rr < 16; ++rr) acc[rr] = -1e30f;
            }
            S[kb] = acc;
        }
        float mx = S[0][0];
#pragma unroll
        for (int kb = 0; kb < 5; ++kb)
#pragma unroll
            for (int rr = 0; rr < 16; ++rr) mx = fmaxf(mx, S[kb][rr]);
        { auto sw = __builtin_amdgcn_permlane32_swap(__float_as_uint(mx), __float_as_uint(mx), false, false); mx = fmaxf(__uint_as_float(sw[0]), __uint_as_float(sw[1])); }
        float lsum = 0.f;
#pragma unroll
        for (int kb = 0; kb < 5; ++kb)
#pragma unroll
            for (int rr = 0; rr < 16; ++rr) { const float p = __builtin_amdgcn_exp2f(S[kb][rr] - mx); S[kb][rr] = p; lsum += p; }
        { auto sw = __builtin_amdgcn_permlane32_swap(__float_as_uint(lsum), __float_as_uint(lsum), false, false); lsum = __uint_as_float(sw[0]) + __uint_as_float(sw[1]); }
        asm volatile("" : "+v"(qn[0]), "+v"(qn[1]), "+v"(qn[2]), "+v"(qn[3]));
        asm volatile("s_waitcnt lgkmcnt(0)\n\ts_barrier" ::: "memory");
        if (has_next) { att_issue_k(nxt, kl, wave, lane); asm volatile("s_waitcnt vmcnt(6)\n\ts_barrier" ::: "memory"); }
        else asm volatile("s_waitcnt vmcnt(0)\n\ts_barrier" ::: "memory");
        f32x16 o[2]; o[0] = f32x16{}; o[1] = f32x16{};
#pragma unroll
        for (int kb = 0; kb < 5; ++kb)
#pragma unroll
            for (int s = 0; s < 2; ++s) {
                v4u pw; pw.x = cvtpk_s(S[kb][8 * s + 0], S[kb][8 * s + 1]); pw.y = cvtpk_s(S[kb][8 * s + 2], S[kb][8 * s + 3]); pw.z = cvtpk_s(S[kb][8 * s + 4], S[kb][8 * s + 5]); pw.w = cvtpk_s(S[kb][8 * s + 6], S[kb][8 * s + 7]);
                const pg8::bf16x8 pa = __builtin_bit_cast(pg8::bf16x8, pw);
                const int kg = 2 * (wave + kb) + s;
#pragma unroll
                for (int d0 = 0; d0 < 2; ++d0) {
                    const LAS unsigned char* vp = VL + (d0 * 24 + kg) * 1024 + vlane;
                    const s16x4 lo = vtr(vp), hh = vtr(vp + 512);
                    const pg8::bf16x8 vb = (pg8::bf16x8){lo[0], lo[1], lo[2], lo[3], hh[0], hh[1], hh[2], hh[3]};
                    o[d0] = __builtin_amdgcn_mfma_f32_32x32x16_bf16(pa, vb, o[d0], 0, 0, 0);
                }
            }
        if (hi == 0) { wsf[r32] = __builtin_amdgcn_rcpf(lsum); lse[((size_t)g * M + rowbase + (size_t)d * (j0 + 32 * wave + r32)) * 8 + h] = mx + __builtin_amdgcn_logf(lsum); }
        asm volatile("s_waitcnt lgkmcnt(0)" ::: "memory");
#pragma unroll
        for (int rr = 0; rr < 16; ++rr) { const int orow = crow(rr, hi); const float il = wsf[orow];
            stg[orow * 64 + r32] = (bf16)f2bf(o[0][rr] * il); stg[orow * 64 + 32 + r32] = (bf16)f2bf(o[1][rr] * il); }
        asm volatile("s_waitcnt lgkmcnt(0)" ::: "memory");
        bf16* ob = og + (size_t)g * M * 512 + h * 64;
#pragma unroll
        for (int k = 0; k < 4; ++k) { const int row = k * 8 + (lane >> 3), ch = lane & 7; const v4u v = *(const LAS v4u*)(stg + row * 64 + ch * 8);
            *(v4u*)(ob + (rowbase + (size_t)d * (j0 + 32 * wave + row)) * 512 + ch * 8) = v; }
        asm volatile("s_waitcnt lgkmcnt(0)" ::: "memory");
        cur = nxt;
    }
    asm volatile("s_waitcnt vmcnt(0) lgkmcnt(0)\n\ts_barrier" ::: "memory");
}

constexpr int P3_TB = 32, P3_ROWS = P3_TB + CONVW - 1, P3_DT = 0, P3_WT = 65536, P3_UNITS = M / P3_TB;
typedef float f32x2 __attribute__((ext_vector_type(2)));
__device__ __forceinline__ void p3_conv_cat(Frame& F, const Args& a) {
    const bf16* hg = (const bf16*)((unsigned char*)a.out + OUT_HGLU); const bf16* yb = (const bf16*)((unsigned char*)a.out + OUT_OG); const float* lse = (const float*)(a.ws + WS_LSE); bf16* cat = (bf16*)(a.ws + WS_R2);
    const float* cw = a.in[4]; const float* cb = a.in[5]; const float* lg = a.in[6]; const float* lb = a.in[7];
    const int lane = F.lane, wave = F.wave, c0 = 8 * lane;
    LAS unsigned char* const DT = F.lds + P3_DT; LAS unsigned char* const WT = F.lds + P3_WT;
    for (int j = wave; j < 2 * CONVW; j += NWAVES)
        __builtin_amdgcn_global_load_lds((const unsigned*)(cw + (j >> 1) * CA + c0 + 4 * (j & 1)), (LAS unsigned*)(WT + j * 1024), 16, 0, 0);
    f32x2 bias2v[4], gam[4], bet[4];
#pragma unroll
    for (int q = 0; q < 4; ++q) { bias2v[q] = *(const f32x2*)(cb + c0 + 2 * q); gam[q] = *(const f32x2*)(lg + c0 + 2 * q); bet[q] = *(const f32x2*)(lb + c0 + 2 * q); }
    const int upw = (P3_UNITS + F.G - 1) / F.G;
    for (int i = 0; i < upw; ++i) {
        const int u = F.vcu * upw + i; if (u >= P3_UNITS) break;
        const int t0 = u * P3_TB, ts = t0 & (SEQ - 1);
        for (int r = wave; r < P3_ROWS; r += NWAVES) {
            if (ts - (CONVW - 1) + r >= 0) __builtin_amdgcn_global_load_lds((const unsigned*)(hg + (size_t)(t0 - (CONVW - 1) + r) * CA + c0), (LAS unsigned*)(DT + r * 1024), 16, 0, 0);
            else *(LAS v4u*)(DT + r * 1024 + lane * 16) = (v4u){0u, 0u, 0u, 0u};
        }
        const int hh = lane >> 3; float l3[4][3]; v4u og3[4][3];
#pragma unroll
        for (int j = 0; j < 4; ++j) { const size_t row = (size_t)t0 + 4 * wave + j;
#pragma unroll
            for (int g = 0; g < 3; ++g) { l3[j][g] = lse[((size_t)g * M + row) * 8 + hh]; og3[j][g] = *(const v4u*)(yb + ((size_t)g * M + row) * 512 + c0); } }
        asm volatile("s_waitcnt vmcnt(0)" ::: "memory");
        __syncthreads();
        f32x2 acc[4][4];
#pragma unroll
        for (int j = 0; j < 4; ++j)
#pragma unroll
            for (int q = 0; q < 4; ++q) acc[j][q] = bias2v[q];
        f32x2 wv[4][4];
#pragma unroll
        for (int r = 0; r < P3_TB / NWAVES + CONVW - 1; ++r) {
            const v4u d = *(const LAS v4u*)(DT + (4 * wave + r) * 1024 + lane * 16);
            const f32x2 x0 = {bflo(d.x), bfhi(d.x)}, x1 = {bflo(d.y), bfhi(d.y)}, x2 = {bflo(d.z), bfhi(d.z)}, x3 = {bflo(d.w), bfhi(d.w)};
            if (r < CONVW) { const f32x4 w0 = *(const LAS f32x4*)(WT + (2 * r) * 1024 + lane * 16), w1 = *(const LAS f32x4*)(WT + (2 * r + 1) * 1024 + lane * 16);
                wv[r & 3][0] = (f32x2){w0[0], w0[1]}; wv[r & 3][1] = (f32x2){w0[2], w0[3]}; wv[r & 3][2] = (f32x2){w1[0], w1[1]}; wv[r & 3][3] = (f32x2){w1[2], w1[3]}; }
#pragma unroll
            for (int j = 0; j < 4; ++j) { const int k = r - j;
                if (k >= 0 && k < CONVW) { acc[j][0] += wv[k & 3][0] * x0; acc[j][1] += wv[k & 3][1] * x1; acc[j][2] += wv[k & 3][2] * x2; acc[j][3] += wv[k & 3][3] * x3; } }
        }
#pragma unroll
        for (int j = 0; j < 4; ++j) {
            const size_t row = (size_t)t0 + 4 * wave + j;
            float s = (acc[j][0][0] + acc[j][0][1]) + (acc[j][1][0] + acc[j][1][1]) + (acc[j][2][0] + acc[j][2][1]) + (acc[j][3][0] + acc[j][3][1]);
            const float mu = wave_sum(s) * (1.0f / CA); float qq = 0.f;
#pragma unroll
            for (int q = 0; q < 4; ++q) { acc[j][q] -= mu; qq += acc[j][q][0] * acc[j][q][0] + acc[j][q][1] * acc[j][q][1]; }
            const float rstd = __builtin_amdgcn_rsqf(wave_sum(qq) * (1.0f / CA) + LN_EPS);
            float y[8];
#pragma unroll
            for (int q = 0; q < 4; ++q) { const f32x2 v = acc[j][q] * rstd * gam[q] + bet[q];
                y[2 * q] = v[0] * __builtin_amdgcn_rcpf(1.0f + __builtin_amdgcn_exp2f(-LOG2E * v[0])); y[2 * q + 1] = v[1] * __builtin_amdgcn_rcpf(1.0f + __builtin_amdgcn_exp2f(-LOG2E * v[1])); }
            v4u o; o.x = pk2(y[0], y[1]); o.y = pk2(y[2], y[3]); o.z = pk2(y[4], y[5]); o.w = pk2(y[6], y[7]);
            *(v4u*)(cat + row * D + c0) = o;
            const float lm = fmaxf(l3[j][0], fmaxf(l3[j][1], l3[j][2])); float w0 = __builtin_amdgcn_exp2f(l3[j][0] - lm), w1 = __builtin_amdgcn_exp2f(l3[j][1] - lm), w2 = __builtin_amdgcn_exp2f(l3[j][2] - lm);
            const float iw = __builtin_amdgcn_rcpf(w0 + w1 + w2); w0 *= iw; w1 *= iw; w2 *= iw;
            const v4u a0 = og3[j][0], a1 = og3[j][1], a2 = og3[j][2]; v4u rr;
            rr.x = pk2(w0 * bflo(a0.x) + w1 * bflo(a1.x) + w2 * bflo(a2.x), w0 * bfhi(a0.x) + w1 * bfhi(a1.x) + w2 * bfhi(a2.x));
            rr.y = pk2(w0 * bflo(a0.y) + w1 * bflo(a1.y) + w2 * bflo(a2.y), w0 * bfhi(a0.y) + w1 * bfhi(a1.y) + w2 * bfhi(a2.y));
            rr.z = pk2(w0 * bflo(a0.z) + w1 * bflo(a1.z) + w2 * bflo(a2.z), w0 * bfhi(a0.z) + w1 * bfhi(a1.z) + w2 * bfhi(a2.z));
            rr.w = pk2(w0 * bflo(a0.w) + w1 * bflo(a1.w) + w2 * bflo(a2.w), w0 * bfhi(a0.w) + w1 * bfhi(a1.w) + w2 * bfhi(a2.w));
            *(v4u*)(cat + row * D + CA + c0) = rr;
        }
        asm volatile("s_waitcnt lgkmcnt(0)" ::: "memory");
        __syncthreads();
    }
}

__device__ __forceinline__ void p8_shortconv(Frame& F, const Args& a) {
    const bf16* bg = (const bf16*)(a.ws + WS_R2); const bf16* cv = (const bf16*)(a.ws + WS_R2 + 64 * MiB); bf16* y = (bf16*)(a.ws + WS_R2 + 128 * MiB);
    const float* w = a.in[11];
    const int c0 = 8 * (F.tid & 127), rsub = F.tid >> 7;
    f32x2 wk[3][4];
#pragma unroll
    for (int k = 0; k < 3; ++k)
#pragma unroll
        for (int q = 0; q < 4; ++q) wk[k][q] = *(const f32x2*)(w + k * D + c0 + 2 * q);
    constexpr int NU = M / 32; const int upw = (NU + F.G - 1) / F.G;
    for (int i = 0; i < upw; ++i) {
        const int u = F.vcu * upw + i; if (u >= NU) break;
        const int r0 = u * 32 + rsub * 8, t = r0 & (SEQ - 1);
        v4u xc[10], xb8[8];
#pragma unroll
        for (int j = 0; j < 10; ++j) xc[j] = (t + j - 2 >= 0) ? *(const v4u*)(cv + (size_t)(r0 + j - 2) * D + c0) : (v4u){0u, 0u, 0u, 0u};
#pragma unroll
        for (int j = 0; j < 8; ++j) xb8[j] = *(const v4u*)(bg + (size_t)(r0 + j) * D + c0);
#pragma unroll
        for (int j = 0; j < 8; ++j) {
            f32x2 acc[4] = {{0.f, 0.f}, {0.f, 0.f}, {0.f, 0.f}, {0.f, 0.f}};
#pragma unroll
            for (int k = 0; k < 3; ++k) { const v4u x = xc[j + k];
                acc[0] += wk[k][0] * (f32x2){bflo(x.x), bfhi(x.x)}; acc[1] += wk[k][1] * (f32x2){bflo(x.y), bfhi(x.y)}; acc[2] += wk[k][2] * (f32x2){bflo(x.z), bfhi(x.z)}; acc[3] += wk[k][3] * (f32x2){bflo(x.w), bfhi(x.w)}; }
            const v4u b = xb8[j];
            v4u o; o.x = pk2(acc[0][0] * bflo(b.x), acc[0][1] * bfhi(b.x)); o.y = pk2(acc[1][0] * bflo(b.y), acc[1][1] * bfhi(b.y)); o.z = pk2(acc[2][0] * bflo(b.z), acc[2][1] * bfhi(b.z)); o.w = pk2(acc[3][0] * bflo(b.w), acc[3][1] * bfhi(b.w));
            *(v4u*)(y + (size_t)(r0 + j) * D + c0) = o;
        }
    }
}

__device__ __forceinline__ void p12_final_norm(Frame& F, const Args& a) {
    const float* stats = (const float*)(a.ws + WS_STATS); const bf16* xb = (const bf16*)(a.ws + WS_XB); const float* g = a.in[16]; float* out = a.out;
    const int gw = F.vcu * NWAVES + F.wave, NGW = F.G * NWAVES;
    f32x4 gv[4];
#pragma unroll
    for (int j = 0; j < 4; ++j) gv[j] = *(const f32x4*)(g + 8 * F.lane + 512 * (j >> 1) + 4 * (j & 1));
    for (int row = gw; row < M; row += NGW) {
        float s = stats[(size_t)row * 16 + (F.lane & 15)];
        s += __shfl_xor(s, 1); s += __shfl_xor(s, 2); s += __shfl_xor(s, 4); s += __shfl_xor(s, 8);
        const float rstd = 1.0f / sqrtf(s * (1.0f / D) + RMS_EPS);
#pragma unroll
        for (int j = 0; j < 2; ++j) {
            const v4u w = *(const v4u*)(xb + (size_t)row * D + 8 * F.lane + 512 * j);
            const f32x4 v0 = (f32x4){bflo(w.x), bfhi(w.x), bflo(w.y), bfhi(w.y)}, v1 = (f32x4){bflo(w.z), bfhi(w.z), bflo(w.w), bfhi(w.w)};
            float* o = out + (size_t)row * D + 8 * F.lane + 512 * j;
            *(f32x4*)o = v0 * rstd * gv[2 * j]; *(f32x4*)(o + 4) = v1 * rstd * gv[2 * j + 1];
        }
    }
}

__device__ __forceinline__ void rstab_fill(Frame& F, const pg8::StaticOrder& S, const float* stats) {
    LAS float* tab = (LAS float*)(F.lds + RSTAB_OFF); pg8::Unit u;
    if (F.tid < 256)
        for (int i = 0; S.next(i, u); ++i) {
            const f32x4* p = (const f32x4*)(stats + (size_t)(u.pm * 256 + F.tid) * 16);
            const f32x4 a = p[0], b = p[1], c = p[2], d = p[3];
            const float s = ((a[0] + a[1]) + (a[2] + a[3])) + ((b[0] + b[1]) + (b[2] + b[3])) + ((c[0] + c[1]) + (c[2] + c[3])) + ((d[0] + d[1]) + (d[2] + d[3]));
            tab[i * 256 + F.tid] = __builtin_amdgcn_rsqf(s * (1.0f / D) + RMS_EPS) * pg8::KSC;
        }
    __syncthreads();
}
#ifndef STAG_TICKS
#define STAG_TICKS 0
#endif
__device__ __forceinline__ void stagger(int ticks) {
    if (ticks > 0 && ((blockIdx.x >> 3) & 1)) { const unsigned long long t0 = __builtin_amdgcn_s_memrealtime(); while (__builtin_amdgcn_s_memrealtime() - t0 < (unsigned long long)ticks) __builtin_amdgcn_s_sleep(32); }
}
__global__ void __launch_bounds__(NWAVES * 64, 2) hybrid_fwd(Args args) {
    extern __shared__ __attribute__((aligned(16))) unsigned char lds[];
    Frame F;
    F.lds = (LAS unsigned char*)lds;
    F.MISC = (volatile LAS unsigned*)(F.lds + MISC_OFF);
    F.tid = threadIdx.x; F.lane = F.tid & 63; F.wave = __builtin_amdgcn_readfirstlane(F.tid >> 6);
    F.G = gridDim.x; { const int bx = blockIdx.x; F.vcu = (F.G % 8 == 0) ? (bx % 8) * (F.G / 8) + bx / 8 : bx; }
    unsigned char* ws = args.ws;
    F.ctl = (gu32*)(ws + WS_CTL);
    for (int u = F.tid; u < (LDS_BYTES - LDSCTL_OFF) / 4; u += NWAVES * 64) ((LAS unsigned*)(F.lds + LDSCTL_OFF))[u] = 0u;
    __syncthreads();
    XcdBarrier bar; bar.bar = (unsigned*)(F.ctl + CW_BAR); bar.x = 0; bar.st = nullptr;
    if (N_LAUNCHES == 1) bar = xcd_barrier_post((unsigned*)(F.ctl + CW_BAR), F.MISC + 8);
#ifndef PROBE_BAR2
#define PROBE_BAR2 0
#endif
#define GRID_BAR() do { if (N_LAUNCHES == 1) { xcd_barrier(bar); if (PROBE_BAR2) xcd_barrier(bar); } } while (0)
    const int lo = args.ph_lo, hi = args.ph_hi;
#define IN(k) (lo <= (k) && (k) < hi)
#define BOTH(k) (IN(k) && IN((k) + 1))
    bf16* const xb = (bf16*)(ws + WS_XB); float* const stats = (float*)(ws + WS_STATS);
    bf16* const r2 = (bf16*)(ws + WS_R2);

    if (IN(0)) { REPS(0) { p0_prologue(F, args); } if (BOTH(0)) GRID_BAR(); }
    if (IN(1)) {
        stagger(STAG_TICKS);
        REPS(1) {
        pg8::Gemm g{xb, (const bf16*)(ws + WS_W_IN0), M, N_IN0, D}; pg8::StaticOrder S; S.init(M, N_IN0, F.G, (int)blockIdx.x);
        rstab_fill(F, S, stats);
        pg8::EpiIn0 E{(bf16*)((unsigned char*)args.out + OUT_HGLU), r2, (const LAS float*)(F.lds + RSTAB_OFF), QSCALE, F.lds + ESTG_OFF};
        pg8::gemm_phase<pg8::EpiIn0, pg8::StaticOrder, PG8_ALIGN, PG8_SP2>(F.lds + RING_OFF, g, S, E);
        }
        if (BOTH(1)) GRID_BAR();
    }
    if (IN(2)) { REPS(2) { p2_attention(F, args); } if (BOTH(2)) GRID_BAR(); }
    if (IN(3)) { REPS(3) { p3_conv_cat(F, args); } if (BOTH(3)) GRID_BAR(); }
    if (IN(4)) {
        REPS(4) {
        pg8::Gemm g{r2, (const bf16*)(ws + WS_W_OUT0), M, D, D}; pg8::StaticOrder S; S.init(M, D, F.G, (int)blockIdx.x);
        pg8::EpiRes E{xb, stats, F.lds + ESTG_OFF};
        pg8::gemm_phase<pg8::EpiRes, pg8::StaticOrder, PG8_ALIGN, PG8_SP2>(F.lds + RING_OFF, g, S, E);
        }
        if (BOTH(4)) GRID_BAR();
    }
    if (IN(5)) {
        stagger(STAG_TICKS);
        REPS(5) {
        pg8::Gemm g{xb, (const bf16*)(ws + WS_W_UP0), M, FF, D}; pg8::StaticOrder S; S.init(M, FF, F.G, (int)blockIdx.x);
        rstab_fill(F, S, stats);
        pg8::EpiUp E{r2, (const LAS float*)(F.lds + RSTAB_OFF), F.lds + ESTG_OFF};
        pg8::gemm_phase<pg8::EpiUp, pg8::StaticOrder, PG8_ALIGN, PG8_SP2>(F.lds + RING_OFF, g, S, E);
        }
        if (BOTH(5)) GRID_BAR();
    }
    if (IN(6)) {
        REPS(6) {
        pg8::Gemm g{r2, (const bf16*)(ws + WS_W_DN0), M, D, FF}; pg8::StaticOrder S; S.init(M, D, F.G, (int)blockIdx.x);
        pg8::EpiRes E{xb, stats, F.lds + ESTG_OFF};
        pg8::gemm_phase<pg8::EpiRes, pg8::StaticOrder, PG8_ALIGN, PG8_SP2>(F.lds + RING_OFF, g, S, E);
        }
        if (BOTH(6)) GRID_BAR();
    }
    if (IN(7)) {
        stagger(STAG_TICKS);
        REPS(7) {
        pg8::Gemm g{xb, (const bf16*)(ws + WS_W_IN1), M, N_IN1, D}; pg8::StaticOrder S; S.init(M, N_IN1, F.G, (int)blockIdx.x);
        rstab_fill(F, S, stats);
        pg8::EpiIn1 E{(bf16*)(ws + WS_R2 + 64 * MiB), r2, (const LAS float*)(F.lds + RSTAB_OFF), F.lds + ESTG_OFF};
        pg8::gemm_phase<pg8::EpiIn1, pg8::StaticOrder, PG8_ALIGN, PG8_SP2>(F.lds + RING_OFF, g, S, E);
        }
        if (BOTH(7)) GRID_BAR();
    }
    if (IN(8)) { REPS(8) { p8_shortconv(F, args); } if (BOTH(8)) GRID_BAR(); }
    if (IN(9)) {
        REPS(9) {
        pg8::Gemm g{(const bf16*)(ws + WS_R2 + 128 * MiB), (const bf16*)(ws + WS_W_OUT1), M, D, D}; pg8::StaticOrder S; S.init(M, D, F.G, (int)blockIdx.x);
        pg8::EpiRes E{xb, stats, F.lds + ESTG_OFF};
        pg8::gemm_phase<pg8::EpiRes, pg8::StaticOrder, PG8_ALIGN, PG8_SP2>(F.lds + RING_OFF, g, S, E);
        }
        if (BOTH(9)) GRID_BAR();
    }
    if (IN(10)) {
        stagger(STAG_TICKS);
        REPS(10) {
        pg8::Gemm g{xb, (const bf16*)(ws + WS_W_UP1), M, FF, D}; pg8::StaticOrder S; S.init(M, FF, F.G, (int)blockIdx.x);
        rstab_fill(F, S, stats);
        pg8::EpiUp E{r2, (const LAS float*)(F.lds + RSTAB_OFF), F.lds + ESTG_OFF};
        pg8::gemm_phase<pg8::EpiUp, pg8::StaticOrder, PG8_ALIGN, PG8_SP2>(F.lds + RING_OFF, g, S, E);
        }
        if (BOTH(10)) GRID_BAR();
    }
    if (IN(11)) {
        REPS(11) {
        pg8::Gemm g{r2, (const bf16*)(ws + WS_W_DN1), M, D, FF}; pg8::StaticOrder S; S.init(M, D, F.G, (int)blockIdx.x);
#if FUSE_FINAL
        pg8::EpiFinal E{xb, args.out, args.in[16], stats, (unsigned*)(F.ctl + CW_SEAM), (unsigned*)(F.ctl + CW_TMO), F.lds + RING_BYTES};
        pg8::gemm_phase<pg8::EpiFinal, pg8::StaticOrder, true, PG8_SP2>(F.lds + RING_OFF, g, S, E);
#else
        pg8::EpiRes E{xb, stats, F.lds + ESTG_OFF};
        pg8::gemm_phase<pg8::EpiRes, pg8::StaticOrder, PG8_ALIGN, PG8_SP2>(F.lds + RING_OFF, g, S, E);
#endif
        }
        if (BOTH(11)) GRID_BAR();
    }
#if !FUSE_FINAL
    if (IN(12)) { p12_final_norm(F, args); }
#endif
#undef IN
#undef BOTH
}

extern "C" void kernel_launch(void* const* d_in, const int* in_sizes, int n_in, void* d_out, int out_size, void* d_ws, size_t ws_size, hipStream_t stream) {
    static int grid = 0;
    if (grid == 0) {
        if (n_in != 17 || in_sizes[0] != M * D || out_size != M * D || ws_size < WS_END) { fprintf(stderr, "kernel_launch: shape/workspace mismatch (n_in %d in0 %d out %d ws %zu, need %zu)\n", n_in, n_in > 0 ? in_sizes[0] : -1, out_size, ws_size, (size_t)WS_END); grid = -1; return; }
        int dev = 0, cus = 0, per_cu = 0;
        if (hipGetDevice(&dev) != hipSuccess || hipDeviceGetAttribute(&cus, hipDeviceAttributeMultiprocessorCount, dev) != hipSuccess) { grid = -1; return; }
        if (hipFuncSetAttribute((const void*)hybrid_fwd, hipFuncAttributeMaxDynamicSharedMemorySize, LDS_BYTES) != hipSuccess) { fprintf(stderr, "kernel_launch: hipFuncSetAttribute failed\n"); grid = -1; return; }
        if (hipOccupancyMaxActiveBlocksPerMultiprocessor(&per_cu, (const void*)hybrid_fwd, NWAVES * 64, LDS_BYTES) != hipSuccess || per_cu < 1) { fprintf(stderr, "kernel_launch: occupancy query says %d workgroups per CU\n", per_cu); }
        (void)hipGetLastError();
        grid = cus;
    }
    if (grid < 0) return;
    if (hipMemsetAsync((char*)d_ws + WS_CTL, 0, CTL_ZERO_BYTES, stream) != hipSuccess) return;
    Args a{};
    for (int i = 0; i < 17; ++i) a.in[i] = (const float*)d_in[i];
    a.out = (float*)d_out; a.ws = (unsigned char*)d_ws;
    for (int li = 0; li < N_LAUNCHES; ++li) {
        a.ph_lo = (N_LAUNCHES == 1) ? 0 : li; a.ph_hi = (N_LAUNCHES == 1) ? N_PHASES : li + 1; a.li = li;
        hipLaunchKernelGGL(hybrid_fwd, dim3(grid), dim3(NWAVES * 64), LDS_BYTES, stream, a);
    }
}
```

```cpp
#include <hip/hip_runtime.h>
#include <cstdio>
#include <cstdint>
#ifndef PG8_BAL
#define PG8_BAL 1
#endif
namespace pg8 {
#define PG8_LAS __attribute__((address_space(3)))
typedef unsigned short bf16_t;
typedef short bf16x8 __attribute__((ext_vector_type(8)));
typedef float f32x4 __attribute__((ext_vector_type(4)));
typedef unsigned u32x4 __attribute__((ext_vector_type(4)));
constexpr int BM = 256, BK = 64, HALF = 128, HTB = HALF * BK * 2  , STAGE_BYTES = 8 * HTB, NXCD = 8, WGM = 8;

__host__ __device__ __forceinline__ int lds_byte(int r, int c) { const int st = (r >> 4) * 2 + (c >> 5), rr = r & 15, cc = c & 31, ob = rr * 64 + cc * 2; return st * 1024 + (ob ^ (((ob >> 9) & 1) << 5)); }
__host__ __device__ __forceinline__ void stage_rc(int b, int& R, int& C) { const int st = b / 1024, sb = b % 1024, swz = sb ^ (((sb >> 9) & 1) << 5); R = (st >> 1) * 16 + swz / 64; C = (st & 1) * 32 + (swz % 64) / 2; }
__host__ __device__ __forceinline__ int perm32(int rho) { const int n = rho >> 4, i = rho & 15; return 8 * (i >> 2) + 4 * n + (i & 3); }

struct Unit { int pm, pn, idx; };
struct Gemm { const bf16_t* A; const bf16_t* Bt; int M, N, K; };

struct StaticOrder {
    int nM, nN, nwg, G, c;
    __host__ __device__ void init(int M, int N, int G_, int c_) { nM = M / BM; nN = N / BM; nwg = nM * nN; G = G_; c = c_; }
    __host__ __device__ bool next(int i, Unit& u) const {
        const long L = (long)i * G + c; if (L >= nwg) return false;
        int wgid = (int)L; { const int q = nwg / NXCD, r = nwg % NXCD, xcd = wgid % NXCD, off = wgid / NXCD; wgid = (xcd < r ? xcd * (q + 1) : r * (q + 1) + (xcd - r) * q) + off; }
        const int nig = WGM * nN, gid = wgid / nig, fm = gid * WGM, gsz = (nM - fm) < WGM ? (nM - fm) : WGM;
        u.pm = fm + ((wgid % nig) % gsz); u.pn = (wgid % nig) / gsz; u.idx = i; return true;
    }
    __device__ __forceinline__ void a_ready(const Unit&) const {}
    __device__ __forceinline__ void done(const Unit&) const {}
};
__device__ __forceinline__ unsigned cvt_pk_bf16(float lo, float hi) { unsigned r; asm volatile("v_cvt_pk_bf16_f32 %0, %1, %2" : "=v"(r) : "v"(lo), "v"(hi)); return r; }
typedef float f32x2 __attribute__((ext_vector_type(2)));
#if defined(PROBE_KREP)
constexpr float KSC = 1.0f / PROBE_KREP;
#else
constexpr float KSC = 1.0f;
#endif
__device__ __forceinline__ void row_rstd(const PG8_LAS float* rstab, const Unit& u, int wr, int fr, float (&rs)[2][4]) {
#pragma unroll
    for (int ai = 0; ai < 2; ++ai)
#pragma unroll
        for (int m = 0; m < 4; ++m) rs[ai][m] = rstab[u.idx * BM + ai * HALF + wr * 64 + m * 16 + fr];
}
__device__ __forceinline__ u32x4 pack8(const f32x4 a, const f32x4 b) { u32x4 w; w.x = cvt_pk_bf16(a[0], a[1]); w.y = cvt_pk_bf16(a[2], a[3]); w.z = cvt_pk_bf16(b[0], b[1]); w.w = cvt_pk_bf16(b[2], b[3]); return w; }
#ifndef EPI_ST_SC1
#define EPI_ST_SC1 0
#endif
__device__ __forceinline__ void st16(bf16_t* p, const u32x4 v) {
#if EPI_ST_SC1
    asm volatile("global_store_dwordx4 %0, %1, off sc1\n\ts_nop 1" :: "v"(p), "v"(v) : "memory");
#else
    *(u32x4*)p = v;
#endif
}
__device__ __forceinline__ void stage16(PG8_LAS unsigned char* stg, int fr, int fq, const u32x4 v0, const u32x4 v1, u32x4& r0, u32x4& r1) {
    const int lane = fr + 16 * fq, x = fr & 7;
    *(PG8_LAS u32x4*)(stg + fr * 128 + ((fq ^ x) << 4)) = v0; *(PG8_LAS u32x4*)(stg + fr * 128 + (((4 + fq) ^ x) << 4)) = v1;
    const int rr = lane >> 3, c = lane & 7;
    r0 = *(const PG8_LAS u32x4*)(stg + rr * 128 + ((c ^ rr) << 4)); r1 = *(const PG8_LAS u32x4*)(stg + (rr + 8) * 128 + ((c ^ rr) << 4));
}
__device__ __forceinline__ float sigmoidf_(float g) { return __builtin_amdgcn_rcpf(1.0f + __builtin_amdgcn_exp2f(-1.4426950408889634f * g)); }

struct EpiIn0 {
    static constexpr bool WCOLS64 = true, PERM = true, AFTER_DRAIN = false, IDEMP = false;
    bf16_t* hglu; bf16_t* qkv; const PG8_LAS float* rstab; float qscale; PG8_LAS unsigned char* stg0;
    __device__ __forceinline__ void operator()(const f32x4 (&acc)[2][2][4][2], const Unit& u, int wr, int wc, int fr, int fq) const {
        const int row0 = u.pm * BM + wr * 64 + fr;
        float rs[2][4]; row_rstd(rstab, u, wr, fr, rs);
        if (u.pn < 4) {
            const int col0 = u.pn * 128 + wc * 32 + 8 * fq;
#pragma unroll
            for (int ai = 0; ai < 2; ++ai)
#pragma unroll
                for (int m = 0; m < 4; ++m) {
                    const float r = rs[ai][m];
                    f32x4 v0 = acc[ai][0][m][0] * r, v1 = acc[ai][0][m][1] * r; const f32x4 g0 = acc[ai][1][m][0] * r, g1 = acc[ai][1][m][1] * r;
#pragma unroll
                    for (int j = 0; j < 4; ++j) { v0[j] *= sigmoidf_(g0[j]); v1[j] *= sigmoidf_(g1[j]); }
                    st16(hglu + (size_t)(row0 + ai * HALF + m * 16) * 512 + col0, pack8(v0, v1));
                }
        } else {
            const int colt = (u.pn - 4) * BM; const float sc = colt < 1536 ? qscale : 1.0f; const int g2 = 2 * ((colt >> 9) % 3), plane = (colt >> 6) + wc;
            PG8_LAS unsigned char* stg = stg0 + (wr * 4 + wc) * 2048; const int lane = fr + 16 * fq, rr = lane >> 3, c = lane & 7;
#pragma unroll
            for (int ai = 0; ai < 2; ++ai)
#pragma unroll
                for (int m = 0; m < 4; ++m) {
                    const float r = rs[ai][m] * sc; u32x4 o0, o1;
                    stage16(stg, fr, fq, pack8(acc[ai][0][m][0] * r, acc[ai][0][m][1] * r), pack8(acc[ai][1][m][0] * r, acc[ai][1][m][1] * r), o0, o1);
#pragma unroll
                    for (int k = 0; k < 2; ++k) { const int row = u.pm * BM + ai * HALF + wr * 64 + m * 16 + 8 * k + rr, b = row >> 13, p = row & 8191;
                        const int pp = ((p & ((1 << g2) - 1)) << (13 - g2)) + (p >> g2);
                        st16(qkv + ((size_t)((plane * 4 + b) * 8192 + pp) << 6) + 8 * c, k ? o1 : o0); }
                }
        }
    }
};
__device__ __forceinline__ float bflo_(unsigned w) { return __builtin_bit_cast(float, w << 16); }
__device__ __forceinline__ float bfhi_(unsigned w) { return __builtin_bit_cast(float, w & 0xffff0000u); }
__device__ __forceinline__ void unstage16(PG8_LAS unsigned char* stg, int fr, int fq, const u32x4 l0, const u32x4 l1, u32x4& b0, u32x4& b1) {
    const int lane = fr + 16 * fq, rr = lane >> 3, c = lane & 7, x = fr & 7;
    *(PG8_LAS u32x4*)(stg + rr * 128 + ((c ^ rr) << 4)) = l0; *(PG8_LAS u32x4*)(stg + (rr + 8) * 128 + ((c ^ rr) << 4)) = l1;
    b0 = *(const PG8_LAS u32x4*)(stg + fr * 128 + ((fq ^ x) << 4)); b1 = *(const PG8_LAS u32x4*)(stg + fr * 128 + (((4 + fq) ^ x) << 4));
}
struct EpiRes {
    static constexpr bool WCOLS64 = true, PERM = true, AFTER_DRAIN = false, IDEMP = false;
    bf16_t* xb; float* stats; PG8_LAS unsigned char* stg0;
    __device__ __forceinline__ void operator()(const f32x4 (&acc)[2][2][4][2], const Unit& u, int wr, int wc, int fr, int fq) const {
        PG8_LAS unsigned char* stg = stg0 + (wr * 4 + wc) * 2048; const int lane = fr + 16 * fq, rr = lane >> 3, c = lane & 7;
        bf16_t* xw = xb + (size_t)(u.pm * BM + wr * 64 + rr) * 1024 + u.pn * BM + wc * 64 + 8 * c;
        const int row0 = u.pm * BM + wr * 64 + fr;
#pragma unroll
        for (int ai = 0; ai < 2; ++ai)
#pragma unroll
            for (int m = 0; m < 4; ++m) {
                bf16_t* p0 = xw + (size_t)(ai * HALF + m * 16) * 1024; bf16_t* p1 = p0 + 8 * 1024;
                const u32x4 l0 = *(const u32x4*)p0, l1 = *(const u32x4*)p1; u32x4 bq[2];
                unstage16(stg, fr, fq, l0, l1, bq[0], bq[1]);
                float ss = 0.f; u32x4 pk[2];
#pragma unroll
                for (int bj = 0; bj < 2; ++bj) { const u32x4 b = bq[bj];
                    const f32x4 o0 = (f32x4){bflo_(b.x), bfhi_(b.x), bflo_(b.y), bfhi_(b.y)} + acc[ai][bj][m][0] * KSC, o1 = (f32x4){bflo_(b.z), bfhi_(b.z), bflo_(b.w), bfhi_(b.w)} + acc[ai][bj][m][1] * KSC;
                    ss += (o0[0] * o0[0] + o0[1] * o0[1]) + (o0[2] * o0[2] + o0[3] * o0[3]) + (o1[0] * o1[0] + o1[1] * o1[1]) + (o1[2] * o1[2] + o1[3] * o1[3]);
                    pk[bj] = pack8(o0, o1); }
                u32x4 r0, r1; stage16(stg, fr, fq, pk[0], pk[1], r0, r1);
                st16(p0, r0); st16(p1, r1);
                ss += __shfl_xor(ss, 16); ss += __shfl_xor(ss, 32);
                if (fq == 0) stats[(size_t)(row0 + ai * HALF + m * 16) * 16 + u.pn * 4 + wc] = ss;
            }
    }
};
struct EpiFinal {
    static constexpr bool WCOLS64 = false, PERM = true, AFTER_DRAIN = false, IDEMP = false;
    const bf16_t* xb; float* out; const float* gain; float* xslot; unsigned* cnt; unsigned* tmo; PG8_LAS unsigned char* lx;
    __device__ __forceinline__ void operator()(f32x4 (&acc)[2][2][4][2], const Unit& u, int wr, int wc, int fr, int fq) const {
        const int tid = threadIdx.x, lane = tid & 63, wid = __builtin_amdgcn_readfirstlane(tid >> 6);
        PG8_LAS float* P = (PG8_LAS float*)lx; PG8_LAS float* S = (PG8_LAS float*)(lx + 4096); PG8_LAS unsigned* flag = (PG8_LAS unsigned*)(lx + 5120);
        const int rl0 = wr * 64 + fr, col0 = u.pn * BM + wc * 32 + 8 * fq;
#pragma unroll
        for (int ai = 0; ai < 2; ++ai)
#pragma unroll
            for (int m = 0; m < 4; ++m) {
                const int rl = rl0 + ai * HALF + m * 16; const size_t off = (size_t)(u.pm * BM + rl) * 1024 + col0; float ss = 0.f;
#pragma unroll
                for (int bj = 0; bj < 2; ++bj) {
                    const u32x4 b = *(const u32x4*)(xb + off + bj * HALF);
                    const f32x4 o0 = (f32x4){bflo_(b.x), bfhi_(b.x), bflo_(b.y), bfhi_(b.y)} + acc[ai][bj][m][0] * KSC, o1 = (f32x4){bflo_(b.z), bfhi_(b.z), bflo_(b.w), bfhi_(b.w)} + acc[ai][bj][m][1] * KSC;
                    ss += (o0[0] * o0[0] + o0[1] * o0[1]) + (o0[2] * o0[2] + o0[3] * o0[3]) + (o1[0] * o1[0] + o1[1] * o1[1]) + (o1[2] * o1[2] + o1[3] * o1[3]);
                    acc[ai][bj][m][0] = o0; acc[ai][bj][m][1] = o1;
                }
                ss += __shfl_xor(ss, 16); ss += __shfl_xor(ss, 32);
                if (fq == 0) P[rl * 4 + wc] = ss;
            }
        asm volatile("s_waitcnt lgkmcnt(0)" ::: "memory"); __builtin_amdgcn_s_barrier(); asm volatile("" ::: "memory");
        if (tid < 256) { const f32x4 p = *(const PG8_LAS f32x4*)(P + tid * 4);
            __hip_atomic_store(xslot + (size_t)(u.pm * BM + tid) * 4 + u.pn, (p[0] + p[1]) + (p[2] + p[3]), __ATOMIC_RELAXED, __HIP_MEMORY_SCOPE_AGENT); }
        asm volatile("s_waitcnt vmcnt(0)" ::: "memory");
        if (tid < 256 && lane == 0) __hip_atomic_fetch_add(cnt + 64 * u.pm, 1u, __ATOMIC_RELAXED, __HIP_MEMORY_SCOPE_AGENT);
        if (wid == 0) {
            bool dead = false; const unsigned long long t0 = __builtin_amdgcn_s_memrealtime();
            for (;;) {
                if ((unsigned)__builtin_amdgcn_readfirstlane(__hip_atomic_load(cnt + 64 * u.pm, __ATOMIC_RELAXED, __HIP_MEMORY_SCOPE_AGENT)) >= 16u) break;
                if (__builtin_amdgcn_s_memrealtime() - t0 > 2000000ull) { if (lane == 0) __hip_atomic_store(tmo, 1u, __ATOMIC_RELAXED, __HIP_MEMORY_SCOPE_AGENT); dead = true; break; }
                __builtin_amdgcn_s_sleep(2);
            }
            __builtin_amdgcn_fence(__ATOMIC_ACQUIRE, "agent");
            if (lane == 0) flag[0] = dead ? 1u : 0u;
        }
        asm volatile("s_waitcnt vmcnt(0) lgkmcnt(0)" ::: "memory"); __builtin_amdgcn_s_barrier(); asm volatile("" ::: "memory");
        if (tid < 256) { const float* sl = xslot + (size_t)(u.pm * BM + tid) * 4; float q = 0.f;
#pragma unroll
            for (int t = 0; t < 4; ++t) q += __hip_atomic_load(sl + t, __ATOMIC_RELAXED, __HIP_MEMORY_SCOPE_AGENT);
            S[tid] = __builtin_amdgcn_rsqf(q * (1.0f / 1024.0f) + 1e-6f); }
        asm volatile("s_waitcnt lgkmcnt(0)" ::: "memory"); __builtin_amdgcn_s_barrier(); asm volatile("" ::: "memory");
        f32x4 gv[2][2];
#pragma unroll
        for (int bj = 0; bj < 2; ++bj) { gv[bj][0] = *(const f32x4*)(gain + col0 + bj * HALF); gv[bj][1] = *(const f32x4*)(gain + col0 + bj * HALF + 4); }
#pragma unroll
        for (int ai = 0; ai < 2; ++ai)
#pragma unroll
            for (int m = 0; m < 4; ++m) {
                const int rl = rl0 + ai * HALF + m * 16; const float rstd = S[rl]; float* op = out + (size_t)(u.pm * BM + rl) * 1024 + col0;
#pragma unroll
                for (int bj = 0; bj < 2; ++bj) { *(f32x4*)(op + bj * HALF) = acc[ai][bj][m][0] * rstd * gv[bj][0]; *(f32x4*)(op + bj * HALF + 4) = acc[ai][bj][m][1] * rstd * gv[bj][1]; }
            }
    }
};
struct EpiUp {
    static constexpr bool WCOLS64 = true, PERM = true, AFTER_DRAIN = false, IDEMP = false;
    bf16_t* z; const PG8_LAS float* rstab; PG8_LAS unsigned char* stg0;
    __device__ __forceinline__ void operator()(const f32x4 (&acc)[2][2][4][2], const Unit& u, int wr, int wc, int fr, int fq) const {
        float rs[2][4]; row_rstd(rstab, u, wr, fr, rs);
        PG8_LAS unsigned char* stg = stg0 + (wr * 4 + wc) * 2048; const int lane = fr + 16 * fq, rr = lane >> 3, c = lane & 7;
        bf16_t* zb = z + (size_t)(u.pm * BM + wr * 64 + rr) * 4096 + u.pn * BM + wc * 64 + 8 * c;
#pragma unroll
        for (int ai = 0; ai < 2; ++ai)
#pragma unroll
            for (int m = 0; m < 4; ++m) {
                const float r = rs[ai][m]; u32x4 pk[2];
#pragma unroll
                for (int bj = 0; bj < 2; ++bj) {
                    f32x4 a = acc[ai][bj][m][0] * r, b = acc[ai][bj][m][1] * r;
#pragma unroll
                    for (int j = 0; j < 4; ++j) { const float x = fmaxf(a[j], 0.f), y = fmaxf(b[j], 0.f); a[j] = x * x; b[j] = y * y; }
                    pk[bj] = pack8(a, b);
                }
                u32x4 o0, o1; stage16(stg, fr, fq, pk[0], pk[1], o0, o1);
                st16(zb + (size_t)(ai * HALF + m * 16) * 4096, o0); st16(zb + (size_t)(ai * HALF + m * 16 + 8) * 4096, o1);
            }
    }
};
struct EpiIn1 {
    static constexpr bool WCOLS64 = true, PERM = true, AFTER_DRAIN = false, IDEMP = false;
    bf16_t* cv; bf16_t* bg; const PG8_LAS float* rstab; PG8_LAS unsigned char* stg0;
    __device__ __forceinline__ void operator()(const f32x4 (&acc)[2][2][4][2], const Unit& u, int wr, int wc, int fr, int fq) const {
        const int row0 = u.pm * BM + wr * 64 + fr;
        float rs[2][4]; row_rstd(rstab, u, wr, fr, rs);
        if (u.pn < 8) {
            const int col0 = u.pn * 128 + wc * 32 + 8 * fq;
#pragma unroll
            for (int ai = 0; ai < 2; ++ai)
#pragma unroll
                for (int m = 0; m < 4; ++m) {
                    const float r2 = rs[ai][m] * rs[ai][m];
                    st16(cv + (size_t)(row0 + ai * HALF + m * 16) * 1024 + col0, pack8(acc[ai][0][m][0] * acc[ai][1][m][0] * r2, acc[ai][0][m][1] * acc[ai][1][m][1] * r2));
                }
        } else {
            PG8_LAS unsigned char* stg = stg0 + (wr * 4 + wc) * 2048; const int lane = fr + 16 * fq, rr = lane >> 3, c = lane & 7;
            bf16_t* bb = bg + (size_t)(u.pm * BM + wr * 64 + rr) * 1024 + (u.pn - 8) * BM + wc * 64 + 8 * c;
#pragma unroll
            for (int ai = 0; ai < 2; ++ai)
#pragma unroll
                for (int m = 0; m < 4; ++m) {
                    const float r = rs[ai][m]; u32x4 o0, o1;
                    stage16(stg, fr, fq, pack8(acc[ai][0][m][0] * r, acc[ai][0][m][1] * r), pack8(acc[ai][1][m][0] * r, acc[ai][1][m][1] * r), o0, o1);
                    st16(bb + (size_t)(ai * HALF + m * 16) * 1024, o0); st16(bb + (size_t)(ai * HALF + m * 16 + 8) * 1024, o1);
                }
        }
    }
};
template <class Epi, class Sched, bool ALIGN_EPI = false, bool SP2 = false>
__device__ __forceinline__ void gemm_phase(PG8_LAS unsigned char* lds, const Gemm g, const Sched& S, const Epi& E) {
    const int tid = threadIdx.x, wid = __builtin_amdgcn_readfirstlane(tid >> 6), lane = tid & 63, wr = wid >> 2, wc = wid & 3, fr = lane & 15, fq = lane >> 4;
    const int K = g.K, nt = K / BK;
    unsigned voffA[2], voffB[2];
#pragma unroll
    for (int i = 0; i < 2; ++i) { int R, C; stage_rc(tid * 16 + i * 8192, R, C); const int r31_ = Epi::PERM ? perm32(R & 31) : (R & 31); const int Rb = (Epi::WCOLS64 ? 64 : 32) * (R >> 5) + r31_;
        voffA[i] = (unsigned)(R * K + C) * 2u; voffB[i] = (unsigned)(Rb * K + C) * 2u; }
    const size_t kstep = (size_t)(BK * 2);
    const size_t hstep = (size_t)HALF * K * 2;
    const size_t tstep = 2 * hstep;
    const size_t hstepB = Epi::WCOLS64 ? (size_t)32 * K * 2 : hstep;
    const unsigned ldsw = (unsigned)wid * 1024u;
    const int aoff = lds_byte(wr * 64 + fr, fq * 8), boff = lds_byte(wc * 32 + fr, fq * 8);
#define PG8_SA(b, h) (((b) * 2 + (h)) * HTB)
#define PG8_SB(b, h) ((4 + (b) * 2 + (h)) * HTB)
#define PG8_STAGE(bufoff, gbase, voff) do { _Pragma("unroll") for (int _i = 0; _i < 2; ++_i) \
        __builtin_amdgcn_global_load_lds((const unsigned*)((const char*)(gbase) + (voff)[_i]), (PG8_LAS unsigned*)(lds + (bufoff) + ldsw + _i * 8192), 16, 0, 0); } while (0)
#define PG8_LDA(dst, b, h) do { _Pragma("unroll") for (int m = 0; m < 4; ++m) _Pragma("unroll") for (int k = 0; k < 2; ++k) dst[m][k] = *(const PG8_LAS bf16x8*)(lds + PG8_SA(b, h) + aoff + m * 2048 + k * 1024); } while (0)
#define PG8_LDB(dst, b, h) do { _Pragma("unroll") for (int n = 0; n < 2; ++n) _Pragma("unroll") for (int k = 0; k < 2; ++k) dst[n][k] = *(const PG8_LAS bf16x8*)(lds + PG8_SB(b, h) + boff + n * 2048 + k * 1024); } while (0)
#if defined(PROBE_MMA2)
#define PG8_MMA_AGAIN(ai, bj, At, Bt) _Pragma("unroll") for (int m = 0; m < 4; ++m) _Pragma("unroll") for (int n = 0; n < 2; ++n) _Pragma("unroll") for (int k = 0; k < 2; ++k) \
        acc[ai][bj][m][n] = __builtin_amdgcn_mfma_f32_16x16x32_bf16(Bt[n][k], At[m][k], acc[ai][bj][m][n], 0, 0, 0);
#else
#define PG8_MMA_AGAIN(ai, bj, At, Bt)
#endif
#define PG8_MMA(ai, bj, At, Bt) do { __builtin_amdgcn_s_setprio(1); _Pragma("unroll") for (int m = 0; m < 4; ++m) _Pragma("unroll") for (int n = 0; n < 2; ++n) _Pragma("unroll") for (int k = 0; k < 2; ++k) \
        acc[ai][bj][m][n] = __builtin_amdgcn_mfma_f32_16x16x32_bf16(Bt[n][k], At[m][k], acc[ai][bj][m][n], 0, 0, 0); PG8_MMA_AGAIN(ai, bj, At, Bt) __builtin_amdgcn_s_setprio(0); } while (0)
#define PG8_WAIT_V(n) asm volatile("s_waitcnt vmcnt(" #n ")" ::: "memory")
#define PG8_WAIT_L(n) asm volatile("s_waitcnt lgkmcnt(" #n ")" ::: "memory")
#define PG8_BAR __builtin_amdgcn_s_barrier()
#define PG8_SCHED __builtin_amdgcn_sched_barrier(0)
    Unit cur, nxt; int ui = 0;
    if (!S.next(0, cur)) return;
    f32x4 acc[2][2][4][2];
#pragma unroll
    for (int a = 0; a < 2; ++a)
#pragma unroll
        for (int b = 0; b < 2; ++b)
#pragma unroll
            for (int m = 0; m < 4; ++m)
#pragma unroll
                for (int n = 0; n < 2; ++n) acc[a][b][m][n] = (f32x4){0.f, 0.f, 0.f, 0.f};
    bf16x8 At[4][2], B0[2][2], B1[2][2];
    const char* cA = (const char*)g.A + (size_t)cur.pm * tstep; const char* cB = (const char*)g.Bt + (size_t)cur.pn * tstep;
    S.a_ready(cur);
    if constexpr (SP2) {
#if PG8_BAL
        PG8_STAGE(PG8_SB(0, 0), cB, voffB); PG8_STAGE(PG8_SB(0, 1), cB + hstepB, voffB); PG8_STAGE(PG8_SA(0, 0), cA, voffA); PG8_STAGE(PG8_SA(0, 1), cA + hstep, voffA);
        PG8_STAGE(PG8_SB(1, 0), cB + kstep, voffB); PG8_STAGE(PG8_SB(1, 1), cB + hstepB + kstep, voffB);
        if (wr == 1) PG8_BAR;
        PG8_WAIT_V(6); PG8_BAR;
        PG8_WAIT_V(4); PG8_BAR;
#else
        PG8_STAGE(PG8_SB(0, 0), cB, voffB); PG8_STAGE(PG8_SB(0, 1), cB + hstepB, voffB); PG8_STAGE(PG8_SA(0, 0), cA, voffA); PG8_STAGE(PG8_SA(0, 1), cA + hstep, voffA);
        if (wr == 1) PG8_BAR;
        PG8_WAIT_V(2); PG8_BAR;
        PG8_STAGE(PG8_SB(1, 0), cB + kstep, voffB); PG8_STAGE(PG8_SA(1, 0), cA + kstep, voffA); PG8_STAGE(PG8_SB(1, 1), cB + hstepB + kstep, voffB);
        PG8_WAIT_V(6); PG8_BAR;
#endif
    } else {
        PG8_STAGE(PG8_SB(0, 0), cB, voffB); PG8_STAGE(PG8_SA(0, 0), cA, voffA); PG8_STAGE(PG8_SB(0, 1), cB + hstepB, voffB); PG8_STAGE(PG8_SA(0, 1), cA + hstep, voffA);
        if (wr == 1) PG8_BAR;
        PG8_WAIT_V(4); PG8_BAR;
        PG8_STAGE(PG8_SB(1, 0), cB + kstep, voffB); PG8_STAGE(PG8_SA(1, 0), cA + kstep, voffA); PG8_STAGE(PG8_SB(1, 1), cB + hstepB + kstep, voffB);
        PG8_WAIT_V(6); PG8_BAR;
    }
    for (;;) {
        const bool has_next = S.next(ui + 1, nxt);
        const char* nA = has_next ? (const char*)g.A + (size_t)nxt.pm * tstep : cA; const char* nB = has_next ? (const char*)g.Bt + (size_t)nxt.pn * tstep : cB;
#if !defined(PROBE_KREP)
#define PROBE_KREP 1
#endif
#if defined(PROBE_MMA2)
#define PROBE_KLOOP_REP 1
#else
#define PROBE_KLOOP_REP PROBE_KREP
#endif
        for (int tt_ = 0; tt_ < nt * PROBE_KLOOP_REP; tt_ += 2) {
            const int t = tt_ & (nt - 1), t2 = (tt_ + 2) & (nt - 1);
            const bool last = (tt_ == nt * PROBE_KLOOP_REP - 2);
            const char* a1 = cA + (size_t)(t + 1) * kstep;
            const char* a2 = last ? nA : cA + (size_t)t2 * kstep; const char* b2 = last ? nB : cB + (size_t)t2 * kstep;
            const char* a3 = a2 + kstep; const char* b3 = b2 + kstep;
            if (last && has_next) S.a_ready(nxt);
            if constexpr (SP2) {
#if PG8_BAL
            PG8_LDB(B0, 0, 0); PG8_LDB(B1, 0, 1); PG8_SCHED; PG8_LDA(At, 0, 0); PG8_STAGE(PG8_SA(1, 0), a1, voffA); PG8_STAGE(PG8_SA(1, 1), a1 + hstep, voffA);
            PG8_WAIT_V(8); PG8_WAIT_L(0); PG8_BAR; PG8_MMA(0, 0, At, B0); PG8_MMA(0, 1, At, B1); PG8_BAR; PG8_SCHED;
            PG8_LDA(At, 0, 1); PG8_STAGE(PG8_SB(0, 0), b2, voffB); PG8_STAGE(PG8_SB(0, 1), b2 + hstepB, voffB);
            PG8_WAIT_V(6); PG8_WAIT_L(0); PG8_BAR; PG8_MMA(1, 0, At, B0); PG8_MMA(1, 1, At, B1); PG8_BAR; PG8_SCHED;
            PG8_LDB(B0, 1, 0); PG8_LDB(B1, 1, 1); PG8_SCHED; PG8_LDA(At, 1, 0); PG8_STAGE(PG8_SA(0, 0), a2, voffA); PG8_STAGE(PG8_SA(0, 1), a2 + hstep, voffA);
            PG8_WAIT_V(8); PG8_WAIT_L(0); PG8_BAR; PG8_MMA(0, 0, At, B0); PG8_MMA(0, 1, At, B1); PG8_BAR; PG8_SCHED;
            PG8_LDA(At, 1, 1); PG8_STAGE(PG8_SB(1, 0), b3, voffB); PG8_STAGE(PG8_SB(1, 1), b3 + hstepB, voffB);
            PG8_WAIT_V(6); PG8_WAIT_L(0); PG8_BAR; PG8_MMA(1, 0, At, B0); PG8_MMA(1, 1, At, B1); PG8_BAR; PG8_SCHED;
#else
            PG8_LDB(B0, 0, 0); PG8_LDB(B1, 0, 1); PG8_SCHED; PG8_LDA(At, 0, 0); PG8_STAGE(PG8_SA(1, 1), a1 + hstep, voffA);
            PG8_WAIT_V(8); PG8_WAIT_L(0); PG8_BAR; PG8_MMA(0, 0, At, B0); PG8_MMA(0, 1, At, B1); PG8_BAR; PG8_SCHED;
            PG8_LDA(At, 0, 1); PG8_STAGE(PG8_SB(0, 0), b2, voffB); PG8_STAGE(PG8_SB(0, 1), b2 + hstepB, voffB); PG8_STAGE(PG8_SA(0, 0), a2, voffA);
            PG8_WAIT_V(8); PG8_WAIT_L(0); PG8_BAR; PG8_MMA(1, 0, At, B0); PG8_MMA(1, 1, At, B1); PG8_BAR; PG8_SCHED;
            PG8_LDB(B0, 1, 0); PG8_LDB(B1, 1, 1); PG8_SCHED; PG8_LDA(At, 1, 0); PG8_STAGE(PG8_SA(0, 1), a2 + hstep, voffA);
            PG8_WAIT_V(8); PG8_WAIT_L(0); PG8_BAR; PG8_MMA(0, 0, At, B0); PG8_MMA(0, 1, At, B1); PG8_BAR; PG8_SCHED;
            PG8_LDA(At, 1, 1); PG8_STAGE(PG8_SB(1, 0), b3, voffB); PG8_STAGE(PG8_SB(1, 1), b3 + hstepB, voffB); PG8_STAGE(PG8_SA(1, 0), a3, voffA);
            PG8_WAIT_V(8); PG8_WAIT_L(0); PG8_BAR; PG8_MMA(1, 0, At, B0); PG8_MMA(1, 1, At, B1); PG8_BAR; PG8_SCHED;
#endif
            } else {
            PG8_LDB(B0, 0, 0); PG8_SCHED; PG8_LDA(At, 0, 0); PG8_STAGE(PG8_SA(1, 1), a1 + hstep, voffA);
            PG8_WAIT_L(8); PG8_BAR; PG8_WAIT_L(0); PG8_MMA(0, 0, At, B0); PG8_BAR; PG8_SCHED;
            PG8_LDB(B1, 0, 1); PG8_STAGE(PG8_SB(0, 0), b2, voffB);
            PG8_BAR; PG8_WAIT_L(0); PG8_MMA(0, 1, At, B1); PG8_BAR;
            PG8_LDA(At, 0, 1); PG8_STAGE(PG8_SA(0, 0), a2, voffA);
            PG8_BAR; PG8_WAIT_L(0); PG8_MMA(1, 0, At, B0); PG8_BAR; PG8_SCHED;
            PG8_STAGE(PG8_SB(0, 1), b2 + hstepB, voffB);
            PG8_WAIT_V(6); PG8_BAR; PG8_MMA(1, 1, At, B1); PG8_BAR;
            PG8_LDB(B0, 1, 0); PG8_SCHED; PG8_LDA(At, 1, 0); PG8_STAGE(PG8_SA(0, 1), a2 + hstep, voffA);
            PG8_WAIT_L(8); PG8_BAR; PG8_WAIT_L(0); PG8_MMA(0, 0, At, B0); PG8_BAR; PG8_SCHED;
            PG8_LDB(B1, 1, 1); PG8_STAGE(PG8_SB(1, 0), b3, voffB);
            PG8_BAR; PG8_WAIT_L(0); PG8_MMA(0, 1, At, B1); PG8_BAR;
            PG8_LDA(At, 1, 1); PG8_STAGE(PG8_SA(1, 0), a3, voffA);
            PG8_BAR; PG8_WAIT_L(0); PG8_MMA(1, 0, At, B0); PG8_BAR; PG8_SCHED;
            PG8_STAGE(PG8_SB(1, 1), b3 + hstepB, voffB);
            PG8_WAIT_V(6); PG8_BAR; PG8_MMA(1, 1, At, B1); PG8_BAR;
            }
        }
        if constexpr (ALIGN_EPI) { if (wr == 0) PG8_BAR; }
        if constexpr (!Epi::AFTER_DRAIN) { E(acc, cur, wr, wc, fr, fq);
#if defined(PROBE_EPI2)
            if constexpr (Epi::IDEMP) { asm volatile("" ::: "memory"); E.probe(acc, cur, wr, wc, fr, fq); }
#endif
            S.done(cur); }
        if (!has_next) break;
#pragma unroll
        for (int a = 0; a < 2; ++a)
#pragma unroll
            for (int b = 0; b < 2; ++b)
#pragma unroll
                for (int m = 0; m < 4; ++m)
#pragma unroll
                    for (int n = 0; n < 2; ++n) acc[a][b][m][n] = (f32x4){0.f, 0.f, 0.f, 0.f};
        cur = nxt; cA = nA; cB = nB; ++ui;
        if constexpr (ALIGN_EPI) { if (wr == 1) PG8_BAR; }
    }
    PG8_WAIT_V(0);
    if constexpr (!ALIGN_EPI) { if (wr == 0) PG8_BAR; }
    PG8_BAR;
    if constexpr (Epi::AFTER_DRAIN) { E.fused(acc, cur, wr, wc, fr, fq, lds, wid, lane); S.done(cur); }
#undef PG8_SA
#undef PG8_SB
#undef PG8_STAGE
#undef PG8_LDA
#undef PG8_LDB
#undef PG8_MMA
#undef PG8_WAIT_V
#undef PG8_WAIT_L
#undef PG8_BAR
#undef PG8_SCHED
}
}
#ifndef PG8_SP2
#define PG8_SP2 true
#endif
#ifndef PG8_ALIGN
#define PG8_ALIGN true
#endif
constexpr int CW_BAR = 4096;
constexpr int CW_TMO = 0, CW_SEAM = 16384;
#define GAS __attribute__((address_space(1)))
#define LAS __attribute__((address_space(3)))
typedef unsigned short bf16;
typedef unsigned v4u __attribute__((ext_vector_type(4)));
typedef float f32x4 __attribute__((ext_vector_type(4)));
typedef short bf16x8 __attribute__((ext_vector_type(8)));
typedef GAS unsigned gu32;
typedef GAS unsigned long long gu64;
#define RLX_AGENT __ATOMIC_RELAXED, __HIP_MEMORY_SCOPE_AGENT
#define LDS_WAIT() asm volatile("s_waitcnt lgkmcnt(0)" ::: "memory")
#define VM_WAIT() asm volatile("s_waitcnt vmcnt(0)" ::: "memory")
__device__ __forceinline__ unsigned long long rt() { return __builtin_amdgcn_s_memrealtime(); }
__device__ __forceinline__ unsigned f2bf(float f) { unsigned u = __builtin_bit_cast(unsigned, f); return (u + 0x7fffu + ((u >> 16) & 1u)) >> 16; }
__device__ __forceinline__ unsigned pk2(float lo, float hi) { return f2bf(lo) | (f2bf(hi) << 16); }

#define XB_TMO      128
#define XB_XCNT(j)  (256  + 64 * (j))
#define XB_XSUB(j)  (1280 + 64 * (j))
#define XB_XGEN(j)  (2304 + 64 * (j))
#define XB_TOP      3328
#define XB_TOPGEN   3392
#define XCD_BAR_WORDS 3456
#define XB_SPIN_CAP (1u << 18)

__device__ __forceinline__ unsigned xb_ld(unsigned* p)              { return __hip_atomic_load(p, __ATOMIC_RELAXED, __HIP_MEMORY_SCOPE_AGENT); }
__device__ __forceinline__ unsigned xb_add(unsigned* p, unsigned v) { return __hip_atomic_fetch_add(p, v, __ATOMIC_RELAXED, __HIP_MEMORY_SCOPE_AGENT); }
__device__ __forceinline__ unsigned xb_xcc_id() { return (unsigned)__builtin_amdgcn_s_getreg((3 << 11) | 20) & 0xFu; }
#define XB_SPIN(cond, bar) do { unsigned _sp = 0; while (cond) { __builtin_amdgcn_s_sleep(1); \
    if ((++_sp & 255u) == 0u) { if (xb_ld(&(bar)[XB_TMO])) break; if (_sp > XB_SPIN_CAP) { atomicAdd(&(bar)[XB_TMO], 1u); break; } } } } while (0)

struct XcdBarrier {
    unsigned* bar; unsigned x;
    volatile LAS unsigned* st;
};

__device__ __forceinline__ XcdBarrier xcd_barrier_post(unsigned* bar, volatile LAS unsigned* st) {
    XcdBarrier b; b.bar = bar; b.x = xb_xcc_id(); b.st = st;
    if (threadIdx.x == 0) (void)xb_add(&bar[XB_XCNT(b.x)], 1u);
    return b;
}
__device__ __forceinline__ void xcd_barrier_complete(unsigned* bar, unsigned x, unsigned& nloc, unsigned& nx) {
    const unsigned G = gridDim.x * gridDim.y * gridDim.z;
    unsigned sum, cnt, mine, sp = 0u;
    for (;;) {
        sum = 0u; cnt = 0u; mine = 0u;
#pragma unroll
        for (unsigned j = 0; j < 16; ++j) { const unsigned c = xb_ld(&bar[XB_XCNT(j)]); sum += c; cnt += (c > 0u) ? 1u : 0u; mine = (j == x) ? c : mine; }
        if (sum == G) break;
        __builtin_amdgcn_s_sleep(1);
        if ((++sp & 255u) == 0u) { if (xb_ld(&bar[XB_TMO])) break; if (sp > XB_SPIN_CAP) { atomicAdd(&bar[XB_TMO], 1u); break; } }
    }
    nloc = mine > 0u ? mine : 1u; nx = cnt > 0u ? cnt : 1u;
}

__device__ __forceinline__ void xcd_barrier(const XcdBarrier& b) {
    asm volatile("s_waitcnt vmcnt(0)" ::: "memory");
    __syncthreads();
    if (threadIdx.x == 0) {
        unsigned* bar = b.bar;
        __builtin_amdgcn_s_waitcnt(0);
        unsigned nloc = b.st[0], nx = b.st[1];
        if (nloc == 0u) { xcd_barrier_complete(bar, b.x, nloc, nx); b.st[0] = nloc; b.st[1] = nx; }
        const unsigned old = xb_add(&bar[XB_XSUB(b.x)], 1u);
        const unsigned gen = old / nloc;
        if (old + 1u == (gen + 1u) * nloc) {
            __builtin_amdgcn_fence(__ATOMIC_RELEASE, "agent");
            asm volatile("s_waitcnt vmcnt(0)" ::: "memory");
            const unsigned og = xb_add(&bar[XB_TOP], 1u);
            const unsigned tg = og / nx;
            if (og + 1u == (tg + 1u) * nx) xb_add(&bar[XB_TOPGEN], 1u);
            else XB_SPIN(xb_ld(&bar[XB_TOPGEN]) == tg, bar);
            __builtin_amdgcn_fence(__ATOMIC_ACQUIRE, "agent");
            xb_add(&bar[XB_XGEN(b.x)], 1u);
            asm volatile("s_waitcnt vmcnt(0)" ::: "memory");
        } else {
            XB_SPIN(xb_ld(&bar[XB_XGEN(b.x)]) == gen, bar);
            __builtin_amdgcn_fence(__ATOMIC_ACQUIRE, "agent");
            asm volatile("s_waitcnt vmcnt(0)" ::: "memory");
        }
    }
    __syncthreads();
}

constexpr int NWAVES = 8;
#ifndef MK_N_LAUNCHES
#define MK_N_LAUNCHES 1
#endif
#ifndef FUSE_FINAL
#define FUSE_FINAL 0
#endif
constexpr int N_PHASES = FUSE_FINAL ? 12 : 13;
#ifndef PROBE_MASK
#define PROBE_MASK 0
#endif
#define REPS(k) for (int rep_ = 0; rep_ < (((PROBE_MASK) >> (k)) & 1) + 1; ++rep_)
constexpr int N_LAUNCHES = MK_N_LAUNCHES;

constexpr int BATCH = 4, SEQ = 8192, D = 1024, M = BATCH * SEQ, FF = 4096, N_IN0 = 5632, N_IN1 = 3072, NQKV = 4608, CA = 512, CONVW = 31;
constexpr float LOG2E = 1.4426950408889634f, QSCALE = 0.125f * LOG2E, RMS_EPS = 1e-6f, LN_EPS = 1e-5f;

constexpr size_t MiB = 1u << 20;
constexpr size_t WS_CTL = 0, CTL_ZERO_BYTES = 1 * MiB;
constexpr size_t WS_STATS = 1 * MiB;
constexpr size_t WS_BIAS2 = 3 * MiB;
constexpr size_t WS_LSE = 4 * MiB;
constexpr size_t WS_W_IN0 = 8 * MiB, WS_W_OUT0 = 19 * MiB, WS_W_UP0 = 21 * MiB, WS_W_DN0 = 29 * MiB, WS_W_IN1 = 37 * MiB, WS_W_OUT1 = 43 * MiB, WS_W_UP1 = 45 * MiB, WS_W_DN1 = 53 * MiB;
constexpr size_t WS_XB = 64 * MiB;
constexpr size_t WS_R2 = 128 * MiB;
constexpr size_t WS_END = 416 * MiB;
constexpr size_t OUT_OG = 0, OUT_HGLU = 96 * MiB;

constexpr int RING_OFF = 0, RING_BYTES = 131072;
constexpr int AT_K = 0, AT_V = 49152, AT_BT = 98304, AT_WS = 118784, AT_OST = 120832, AT_END = 153600;
constexpr int RSTAB_OFF = RING_BYTES, ESTG_OFF = RING_BYTES + 11264;
constexpr int LDSCTL_OFF = 162816, MISC_OFF = LDSCTL_OFF + 320;
constexpr int LDS_BYTES = 163840;
static_assert(ESTG_OFF + 16384 <= LDSCTL_OFF && AT_END <= LDSCTL_OFF, "LDS map");

struct Frame {
    LAS unsigned char* lds;
    volatile LAS unsigned* MISC;
    gu32* ctl;
    int tid, lane, wave;
    int vcu, G;
};
struct Args { const float* in[17]; float* out; unsigned char* ws; int ph_lo, ph_hi, li, pad; };

__device__ __forceinline__ float wave_sum(float v) {
#pragma unroll
    for (int o = 1; o < 64; o <<= 1) v += __shfl_xor(v, o);
    return v;
}
__device__ __forceinline__ float bf2f(unsigned short b) { return __builtin_bit_cast(float, (unsigned)b << 16); }
__device__ __forceinline__ float bflo(unsigned w) { return __builtin_bit_cast(float, w << 16); }
__device__ __forceinline__ float bfhi(unsigned w) { return __builtin_bit_cast(float, w & 0xffff0000u); }

__device__ __forceinline__ int colmap(int mode, int n0) {
    if (mode == 1) { if (n0 < 512) return 256 * (n0 >> 7) + 64 * ((n0 & 127) >> 5) + (n0 & 31); if (n0 < 1024) { const int c = n0 - 512; return 256 * (c >> 7) + 64 * ((c & 127) >> 5) + 32 + (c & 31); } return n0; }
    if (mode == 2) { if (n0 < 1024) return 2048 + n0; if (n0 < 2048) { const int c = n0 - 1024; return 256 * (c >> 7) + 64 * ((c & 127) >> 5) + (c & 31); } const int v = n0 - 2048; return 256 * (v >> 7) + 64 * ((v & 127) >> 5) + 32 + (v & 31); }
    return n0;
}
__device__ __forceinline__ void p0_transpose_item(const float* W, int K, int N, bf16* WT, const float* gain, int mode, LAS float* scr, int item, int lane) {
    const int nblk = N / 64, kb = item / nblk, nb = item % nblk, k0 = 64 * kb, n0 = 64 * nb;
    const int lk = lane >> 4, n4 = 4 * (lane & 15);
#pragma unroll 4
    for (int i = 0; i < 16; ++i) { const int kk = 4 * i + lk; const float g = gain ? gain[k0 + kk] : 1.0f; const f32x4 v = *(const GAS f32x4*)(W + (size_t)(k0 + kk) * N + n0 + n4);
        LAS float* d = scr + kk * 65 + n4; d[0] = g * v.x; d[1] = g * v.y; d[2] = g * v.z; d[3] = g * v.w; }
    LDS_WAIT(); asm volatile("" ::: "memory");
    const int c = lane & 7;
#pragma unroll
    for (int j = 0; j < 8; ++j) { const int n = (lane >> 3) + 8 * j; const LAS float* s = scr + (8 * c) * 65 + n;
        v4u o; o.x = pk2(s[0 * 65], s[1 * 65]); o.y = pk2(s[2 * 65], s[3 * 65]); o.z = pk2(s[4 * 65], s[5 * 65]); o.w = pk2(s[6 * 65], s[7 * 65]);
        *(GAS v4u*)(WT + (size_t)(colmap(mode, n0 + (n & 32)) + (n & 31)) * K + k0 + 8 * c) = o; }
    LDS_WAIT(); asm volatile("" ::: "memory");
}
__device__ __forceinline__ void p0_x_item(const float* x, bf16* xb, float* stats, int item, int lane) {
#pragma unroll
    for (int rr = 0; rr < 4; ++rr) { const int m = 4 * item + rr; float s = 0.f;
#pragma unroll
        for (int hh = 0; hh < 2; ++hh) { const float* p = x + (size_t)m * D + 512 * hh + 8 * lane; const f32x4 a = *(const GAS f32x4*)p, b = *(const GAS f32x4*)(p + 4);
            s += (a.x * a.x + a.y * a.y) + (a.z * a.z + a.w * a.w) + (b.x * b.x + b.y * b.y) + (b.z * b.z + b.w * b.w);
            v4u o; o.x = pk2(a.x, a.y); o.y = pk2(a.z, a.w); o.z = pk2(b.x, b.y); o.w = pk2(b.z, b.w); *(GAS v4u*)(xb + (size_t)m * D + 512 * hh + 8 * lane) = o; }
        s = wave_sum(s);
        if (lane < 16) stats[(size_t)m * 16 + lane] = lane == 0 ? s : 0.f; }
}
__device__ __forceinline__ void p0_prologue(Frame& F, const Args& a) {
    unsigned char* ws = a.ws;
    LAS float* scr = (LAS float*)(F.lds + RING_OFF + F.wave * 16640);
    const int gw = F.vcu * NWAVES + F.wave, NGW = F.G * NWAVES;
    constexpr int I_IN0 = (D / 64) * (N_IN0 / 64), I_SQ = (D / 64) * (D / 64), I_UP = (D / 64) * (FF / 64), I_DN = (FF / 64) * (D / 64), I_IN1 = (D / 64) * (N_IN1 / 64);
    constexpr int NW_ITEMS = I_IN0 + 2 * I_SQ + 2 * I_UP + 2 * I_DN + I_IN1, NITEMS = NW_ITEMS + M / 4;
    const float* x = a.in[0]; bf16* xb = (bf16*)(ws + WS_XB); float* stats = (float*)(ws + WS_STATS);
    for (int it = gw; it < NITEMS; it += NGW) {
        int r = it;
        if (r >= NW_ITEMS) { p0_x_item(x, xb, stats, r - NW_ITEMS, F.lane); continue; }
        if (r < I_IN0) { p0_transpose_item(a.in[3], D, N_IN0, (bf16*)(ws + WS_W_IN0), a.in[2], 1, scr, r, F.lane); continue; } r -= I_IN0;
        if (r < I_SQ) { p0_transpose_item(a.in[8], D, D, (bf16*)(ws + WS_W_OUT0), nullptr, 0, scr, r, F.lane); continue; } r -= I_SQ;
        if (r < I_UP) { p0_transpose_item(a.in[14], D, FF, (bf16*)(ws + WS_W_UP0), a.in[13], 0, scr, r, F.lane); continue; } r -= I_UP;
        if (r < I_DN) { p0_transpose_item(a.in[15], FF, D, (bf16*)(ws + WS_W_DN0), nullptr, 0, scr, r, F.lane); continue; } r -= I_DN;
        if (r < I_IN1) { p0_transpose_item(a.in[10], D, N_IN1, (bf16*)(ws + WS_W_IN1), a.in[9], 2, scr, r, F.lane); continue; } r -= I_IN1;
        if (r < I_SQ) { p0_transpose_item(a.in[12], D, D, (bf16*)(ws + WS_W_OUT1), nullptr, 0, scr, r, F.lane); continue; } r -= I_SQ;
        if (r < I_UP) { p0_transpose_item(a.in[14] + (size_t)D * FF, D, FF, (bf16*)(ws + WS_W_UP1), a.in[13] + D, 0, scr, r, F.lane); continue; } r -= I_UP;
        p0_transpose_item(a.in[15] + (size_t)FF * D, FF, D, (bf16*)(ws + WS_W_DN1), nullptr, 0, scr, r, F.lane);
    }
    if (blockIdx.x == 0) {
        float* b2 = (float*)(ws + WS_BIAS2); const float* rb = a.in[1];
        for (int i = F.tid; i < 24 * 129; i += NWAVES * 64) {
            const int gh = i / 129, m = i % 129, g = gh >> 3, n = m << (2 * g);
            int bucket = n;
            if (n >= 16) { const float nf = (float)n; const int large = 16 + (int)(logf(nf / 16.0f) / logf(128.0f) * 16.0f); bucket = large < 31 ? large : 31; }
            b2[gh * 132 + m] = LOG2E * rb[bucket * 24 + gh];
        }
    }
}

typedef float f32x16 __attribute__((ext_vector_type(16)));
typedef short s16x4 __attribute__((ext_vector_type(4)));
typedef short v4i16_t __attribute__((ext_vector_type(4)));
__device__ __forceinline__ int crow(int r, int hi) { return (r & 3) + 8 * (r >> 2) + 4 * hi; }
__device__ __forceinline__ s16x4 vtr(const LAS unsigned char* p) { return __builtin_bit_cast(s16x4, __builtin_amdgcn_ds_read_tr16_b64_v4i16((LAS v4i16_t*)p)); }
__device__ __forceinline__ unsigned cvtpk_s(float lo, float hi) { typedef float f2 __attribute__((ext_vector_type(2))); typedef __bf16 b2 __attribute__((ext_vector_type(2))); f2 v = {lo, hi}; b2 b = __builtin_convertvector(v, b2); return __builtin_bit_cast(unsigned, b); }
constexpr int ATT_UNITS = BATCH * 3 * 8 * 32;
__device__ __forceinline__ void glds16(const void* gsrc, unsigned lds_dst) { unsigned keep;
    asm volatile("s_mov_b32 %0, m0\n\ts_mov_b32 m0, %2\n\ts_nop 0\n\tglobal_load_lds_dwordx4 %1, off\n\ts_mov_b32 m0, %0" : "=&s"(keep) : "v"(gsrc), "s"(lds_dst) : "memory"); }
struct AttUnit { const bf16* Qb; const bf16* Kb; const bf16* Vb; size_t rowbase; int g, h, gh, d, j0; };
__device__ __forceinline__ AttUnit att_decode(int u, const bf16* qkv) {
    AttUnit t; const int rb = u & 31, b = u / 768; t.h = (u >> 5) & 7; t.g = (u >> 8) % 3; t.gh = t.g * 8 + t.h;
    t.d = 1 << (2 * t.g); const int lgn = 5 - 2 * t.g, r = rb >> lgn; t.j0 = (rb & ((1 << lgn) - 1)) * 256;
    t.rowbase = (size_t)b * SEQ + r;
    t.Qb = qkv + ((size_t)((t.gh * 4 + b) * 8192 + r * (SEQ >> (2 * t.g))) << 6);
    t.Kb = t.Qb + (size_t)24 * 4 * 8192 * 64; t.Vb = t.Kb + (size_t)24 * 4 * 8192 * 64; return t;
}
__device__ __forceinline__ void att_issue_k(const AttUnit& t, unsigned kl, int wave, int lane) {
#pragma unroll
    for (int k = 0; k < 6; ++k) {
        const int inst = wave * 6 + k, tr = 8 * inst + (lane >> 3); int kj = t.j0 - 128 + tr; kj = kj < 0 ? 0 : kj;
        const int c = (lane & 7) ^ ((tr >> 1) & 7);
        glds16(t.Kb + kj * 64 + c * 8, (unsigned)__builtin_amdgcn_readfirstlane((int)(kl + inst * 1024)));
    }
}
__device__ __forceinline__ void att_issue_v(const AttUnit& t, unsigned vl, int wave, int lane) {
#pragma unroll
    for (int k = 0; k < 6; ++k) {
        const int inst = wave * 6 + k, dh = inst / 24, kg = inst % 24, tr = 16 * kg + (lane >> 2); int kj = t.j0 - 128 + tr; kj = kj < 0 ? 0 : kj;
        glds16(t.Vb + kj * 64 + ((lane & 3) + 4 * dh) * 8, (unsigned)__builtin_amdgcn_readfirstlane((int)(vl + inst * 1024)));
    }
}
__device__ __forceinline__ void p2_attention(Frame& F, const Args& a) {
    const bf16* qkv = (const bf16*)(a.ws + WS_R2); bf16* og = (bf16*)((unsigned char*)a.out + OUT_OG); float* lse = (float*)(a.ws + WS_LSE); const float* b2 = (const float*)(a.ws + WS_BIAS2);
    LAS unsigned char* const KL = F.lds + AT_K; LAS unsigned char* const VL = F.lds + AT_V; LAS float* const BT = (LAS float*)(F.lds + AT_BT);
    LAS float* const wsf = (LAS float*)(F.lds + AT_WS) + F.wave * 64; LAS bf16* const stg = (LAS bf16*)(F.lds + AT_OST) + F.wave * 2048;
    const unsigned kl = (unsigned)(uintptr_t)KL, vl = (unsigned)(uintptr_t)VL;
    const int lane = F.lane, wave = F.wave, r32 = lane & 31, hi = lane >> 5;
    const int upw = (ATT_UNITS + F.G - 1) / F.G, u0 = F.vcu * upw;
    int nu = ATT_UNITS - u0; nu = nu < 0 ? 0 : (nu > upw ? upw : nu);
    if (nu == 0) return;
    int prev_gh = -1;
    const int vlane = ((lane >> 4) & 1) * 32 + (lane & 3) * 8 + (4 * hi + ((lane & 15) >> 2)) * 64;
    AttUnit cur = att_decode(u0, qkv);
    att_issue_k(cur, kl, wave, lane);
    pg8::bf16x8 qn[4];
    { const bf16* qp = cur.Qb + (cur.j0 + 32 * wave + r32) * 64 + hi * 8;
#pragma unroll
      for (int d0 = 0; d0 < 4; ++d0) qn[d0] = *(const pg8::bf16x8*)(qp + d0 * 16); }
    asm volatile("" : "+v"(qn[0]), "+v"(qn[1]), "+v"(qn[2]), "+v"(qn[3]));
    for (int i = 0; i < nu; ++i) {
        const bool has_next = (i + 1 < nu);
        const AttUnit nxt = att_decode(has_next ? u0 + i + 1 : u0 + i, qkv);
        const int g = cur.g, h = cur.h, d = cur.d, j0 = cur.j0; const size_t rowbase = cur.rowbase;
        if (cur.gh != prev_gh) {
            prev_gh = cur.gh;
            for (int e = F.tid; e < 5 * 4 * 64 * 4; e += NWAVES * 64) {
                const int ii = e & 3, L = (e >> 2) & 63, r4 = (e >> 8) & 3, kb = e >> 10, q = L & 31, hh = L >> 5;
                const int m = 128 - 32 * kb + q - (8 * r4 + 4 * hh + ii);
                BT[e] = (m >= 0 && m <= 128) ? b2[cur.gh * 132 + m] : -1e30f;
            }
        }
        asm volatile("s_waitcnt vmcnt(0) lgkmcnt(0)\n\ts_barrier" ::: "memory");
        att_issue_v(cur, vl, wave, lane);
        pg8::bf16x8 qr[4];
#pragma unroll
        for (int d0 = 0; d0 < 4; ++d0) qr[d0] = qn[d0];
        if (has_next) { const bf16* qp = nxt.Qb + (nxt.j0 + 32 * wave + r32) * 64 + hi * 8;
#pragma unroll
            for (int d0 = 0; d0 < 4; ++d0) qn[d0] = *(const pg8::bf16x8*)(qp + d0 * 16); }
        f32x16 S[5];
        const bool first = (j0 == 0);
#pragma unroll
        for (int kb = 0; kb < 5; ++kb) {
            f32x16 acc;
#pragma unroll
            for (int r4 = 0; r4 < 4; ++r4) { const f32x4 t = *(const LAS f32x4*)(BT + ((kb * 4 + r4) * 64 + lane) * 4); acc[4 * r4 + 0] = t[0]; acc[4 * r4 + 1] = t[1]; acc[4 * r4 + 2] = t[2]; acc[4 * r4 + 3] = t[3]; }
            const int trow = 32 * (wave + kb) + r32;
#pragma unroll
            for (int d0 = 0; d0 < 4; ++d0) {
                const pg8::bf16x8 kf = *(const LAS pg8::bf16x8*)(KL + trow * 128 + (((2 * d0 + hi) ^ ((trow >> 1) & 7)) << 4));
                acc = __builtin_amdgcn_mfma_f32_32x32x16_bf16(kf, qr[d0], acc, 0, 0, 0);
            }
            if (first && kb < 4 - wave) {
#pragma unroll
                for (int rr = 0; rr < 16; ++rr) acc[rr] = -1e30f;
            }
            S[kb] = acc;
        }
        float mx = S[0][0];
#pragma unroll
        for (int kb = 0; kb < 5; ++kb)
#pragma unroll
            for (int rr = 0; rr < 16; ++rr) mx = fmaxf(mx, S[kb][rr]);
        { auto sw = __builtin_amdgcn_permlane32_swap(__float_as_uint(mx), __float_as_uint(mx), false, false); mx = fmaxf(__uint_as_float(sw[0]), __uint_as_float(sw[1])); }
        float lsum = 0.f;
#pragma unroll
        for (int kb = 0; kb < 5; ++kb)
#pragma unroll
            for (int rr = 0; rr < 16; ++rr) { const float p = __builtin_amdgcn_exp2f(S[kb][rr] - mx); S[kb][rr] = p; lsum += p; }
        { auto sw = __builtin_amdgcn_permlane32_swap(__float_as_uint(lsum), __float_as_uint(lsum), false, false); lsum = __uint_as_float(sw[0]) + __uint_as_float(sw[1]); }
        asm volatile("" : "+v"(qn[0]), "+v"(qn[1]), "+v"(qn[2]), "+v"(qn[3]));
        asm volatile("s_waitcnt lgkmcnt(0)\n\ts_barrier" ::: "memory");
        if (has_next) { att_issue_k(nxt, kl, wave, lane); asm volatile("s_waitcnt vmcnt(6)\n\ts_barrier" ::: "memory"); }
        else asm volatile("s_waitcnt vmcnt(0)\n\ts_barrier" ::: "memory");
        f32x16 o[2]; o[0] = f32x16{}; o[1] = f32x16{};
#pragma unroll
        for (int kb = 0; kb < 5; ++kb)
#pragma unroll
            for (int s = 0; s < 2; ++s) {
                v4u pw; pw.x = cvtpk_s(S[kb][8 * s + 0], S[kb][8 * s + 1]); pw.y = cvtpk_s(S[kb][8 * s + 2], S[kb][8 * s + 3]); pw.z = cvtpk_s(S[kb][8 * s + 4], S[kb][8 * s + 5]); pw.w = cvtpk_s(S[kb][8 * s + 6], S[kb][8 * s + 7]);
                const pg8::bf16x8 pa = __builtin_bit_cast(pg8::bf16x8, pw);
                const int kg = 2 * (wave + kb) + s;
#pragma unroll
                for (int d0 = 0; d0 < 2; ++d0) {
                    const LAS unsigned char* vp = VL + (d0 * 24 + kg) * 1024 + vlane;
                    const s16x4 lo = vtr(vp), hh = vtr(vp + 512);
                    const pg8::bf16x8 vb = (pg8::bf16x8){lo[0], lo[1], lo[2], lo[3], hh[0], hh[1], hh[2], hh[3]};
                    o[d0] = __builtin_amdgcn_mfma_f32_32x32x16_bf16(pa, vb, o[d0], 0, 0, 0);
                }
            }
        if (hi == 0) { wsf[r32] = __builtin_amdgcn_rcpf(lsum); lse[((size_t)g * M + rowbase + (size_t)d * (j0 + 32 * wave + r32)) * 8 + h] = mx + __builtin_amdgcn_logf(lsum); }
        asm volatile("s_waitcnt lgkmcnt(0)" ::: "memory");
#pragma unroll
        for (int rr = 0; rr < 16; ++rr) { const int orow = crow(rr, hi); const float il = wsf[orow];
            stg[orow * 64 + r32] = (bf16)f2bf(o[0][rr] * il); stg[orow * 64 + 32 + r32] = (bf16)f2bf(o[1][rr] * il); }
        asm volatile("s_waitcnt lgkmcnt(0)" ::: "memory");
        bf16* ob = og + (size_t)g * M * 512 + h * 64;
#pragma unroll
        for (int k = 0; k < 4; ++k) { const int row = k * 8 + (lane >> 3), ch = lane & 7; const v4u v = *(const LAS v4u*)(stg + row * 64 + ch * 8);
            *(v4u*)(ob + (rowbase + (size_t)d * (j0 + 32 * wave + row)) * 512 + ch * 8) = v; }
        asm volatile("s_waitcnt lgkmcnt(0)" ::: "memory");
        cur = nxt;
    }
    asm volatile("s_waitcnt vmcnt(0) lgkmcnt(0)\n\ts_barrier" ::: "memory");
}

constexpr int P3_TB = 32, P3_ROWS = P3_TB + CONVW - 1, P3_DT = 0, P3_WT = 65536, P3_UNITS = M / P3_TB;
typedef float f32x2 __attribute__((ext_vector_type(2)));
__device__ __forceinline__ void p3_conv_cat(Frame& F, const Args& a) {
    const bf16* hg = (const bf16*)((unsigned char*)a.out + OUT_HGLU); const bf16* yb = (const bf16*)((unsigned char*)a.out + OUT_OG); const float* lse = (const float*)(a.ws + WS_LSE); bf16* cat = (bf16*)(a.ws + WS_R2);
    const float* cw = a.in[4]; const float* cb = a.in[5]; const float* lg = a.in[6]; const float* lb = a.in[7];
    const int lane = F.lane, wave = F.wave, c0 = 8 * lane;
    LAS unsigned char* const DT = F.lds + P3_DT; LAS unsigned char* const WT = F.lds + P3_WT;
    for (int j = wave; j < 2 * CONVW; j += NWAVES)
        __builtin_amdgcn_global_load_lds((const unsigned*)(cw + (j >> 1) * CA + c0 + 4 * (j & 1)), (LAS unsigned*)(WT + j * 1024), 16, 0, 0);
    f32x2 bias2v[4], gam[4], bet[4];
#pragma unroll
    for (int q = 0; q < 4; ++q) { bias2v[q] = *(const f32x2*)(cb + c0 + 2 * q); gam[q] = *(const f32x2*)(lg + c0 + 2 * q); bet[q] = *(const f32x2*)(lb + c0 + 2 * q); }
    const int upw = (P3_UNITS + F.G - 1) / F.G;
    for (int i = 0; i < upw; ++i) {
        const int u = F.vcu * upw + i; if (u >= P3_UNITS) break;
        const int t0 = u * P3_TB, ts = t0 & (SEQ - 1);
        for (int r = wave; r < P3_ROWS; r += NWAVES) {
            if (ts - (CONVW - 1) + r >= 0) __builtin_amdgcn_global_load_lds((const unsigned*)(hg + (size_t)(t0 - (CONVW - 1) + r) * CA + c0), (LAS unsigned*)(DT + r * 1024), 16, 0, 0);
            else *(LAS v4u*)(DT + r * 1024 + lane * 16) = (v4u){0u, 0u, 0u, 0u};
        }
        const int hh = lane >> 3; float l3[4][3]; v4u og3[4][3];
#pragma unroll
        for (int j = 0; j < 4; ++j) { const size_t row = (size_t)t0 + 4 * wave + j;
#pragma unroll
            for (int g = 0; g < 3; ++g) { l3[j][g] = lse[((size_t)g * M + row) * 8 + hh]; og3[j][g] = *(const v4u*)(yb + ((size_t)g * M + row) * 512 + c0); } }
        asm volatile("s_waitcnt vmcnt(0)" ::: "memory");
        __syncthreads();
        f32x2 acc[4][4];
#pragma unroll
        for (int j = 0; j < 4; ++j)
#pragma unroll
            for (int q = 0; q < 4; ++q) acc[j][q] = bias2v[q];
        f32x2 wv[4][4];
#pragma unroll
        for (int r = 0; r < P3_TB / NWAVES + CONVW - 1; ++r) {
            const v4u d = *(const LAS v4u*)(DT + (4 * wave + r) * 1024 + lane * 16);
            const f32x2 x0 = {bflo(d.x), bfhi(d.x)}, x1 = {bflo(d.y), bfhi(d.y)}, x2 = {bflo(d.z), bfhi(d.z)}, x3 = {bflo(d.w), bfhi(d.w)};
            if (r < CONVW) { const f32x4 w0 = *(const LAS f32x4*)(WT + (2 * r) * 1024 + lane * 16), w1 = *(const LAS f32x4*)(WT + (2 * r + 1) * 1024 + lane * 16);
                wv[r & 3][0] = (f32x2){w0[0], w0[1]}; wv[r & 3][1] = (f32x2){w0[2], w0[3]}; wv[r & 3][2] = (f32x2){w1[0], w1[1]}; wv[r & 3][3] = (f32x2){w1[2], w1[3]}; }
#pragma unroll
            for (int j = 0; j < 4; ++j) { const int k = r - j;
                if (k >= 0 && k < CONVW) { acc[j][0] += wv[k & 3][0] * x0; acc[j][1] += wv[k & 3][1] * x1; acc[j][2] += wv[k & 3][2] * x2; acc[j][3] += wv[k & 3][3] * x3; } }
        }
#pragma unroll
        for (int j = 0; j < 4; ++j) {
            const size_t row = (size_t)t0 + 4 * wave + j;
            float s = (acc[j][0][0] + acc[j][0][1]) + (acc[j][1][0] + acc[j][1][1]) + (acc[j][2][0] + acc[j][2][1]) + (acc[j][3][0] + acc[j][3][1]);
            const float mu = wave_sum(s) * (1.0f / CA); float qq = 0.f;
#pragma unroll
            for (int q = 0; q < 4; ++q) { acc[j][q] -= mu; qq += acc[j][q][0] * acc[j][q][0] + acc[j][q][1] * acc[j][q][1]; }
            const float rstd = __builtin_amdgcn_rsqf(wave_sum(qq) * (1.0f / CA) + LN_EPS);
            float y[8];
#pragma unroll
            for (int q = 0; q < 4; ++q) { const f32x2 v = acc[j][q] * rstd * gam[q] + bet[q];
                y[2 * q] = v[0] * __builtin_amdgcn_rcpf(1.0f + __builtin_amdgcn_exp2f(-LOG2E * v[0])); y[2 * q + 1] = v[1] * __builtin_amdgcn_rcpf(1.0f + __builtin_amdgcn_exp2f(-LOG2E * v[1])); }
            v4u o; o.x = pk2(y[0], y[1]); o.y = pk2(y[2], y[3]); o.z = pk2(y[4], y[5]); o.w = pk2(y[6], y[7]);
            *(v4u*)(cat + row * D + c0) = o;
            const float lm = fmaxf(l3[j][0], fmaxf(l3[j][1], l3[j][2])); float w0 = __builtin_amdgcn_exp2f(l3[j][0] - lm), w1 = __builtin_amdgcn_exp2f(l3[j][1] - lm), w2 = __builtin_amdgcn_exp2f(l3[j][2] - lm);
            const float iw = __builtin_amdgcn_rcpf(w0 + w1 + w2); w0 *= iw; w1 *= iw; w2 *= iw;
            const v4u a0 = og3[j][0], a1 = og3[j][1], a2 = og3[j][2]; v4u rr;
            rr.x = pk2(w0 * bflo(a0.x) + w1 * bflo(a1.x) + w2 * bflo(a2.x), w0 * bfhi(a0.x) + w1 * bfhi(a1.x) + w2 * bfhi(a2.x));
            rr.y = pk2(w0 * bflo(a0.y) + w1 * bflo(a1.y) + w2 * bflo(a2.y), w0 * bfhi(a0.y) + w1 * bfhi(a1.y) + w2 * bfhi(a2.y));
            rr.z = pk2(w0 * bflo(a0.z) + w1 * bflo(a1.z) + w2 * bflo(a2.z), w0 * bfhi(a0.z) + w1 * bfhi(a1.z) + w2 * bfhi(a2.z));
            rr.w = pk2(w0 * bflo(a0.w) + w1 * bflo(a1.w) + w2 * bflo(a2.w), w0 * bfhi(a0.w) + w1 * bfhi(a1.w) + w2 * bfhi(a2.w));
            *(v4u*)(cat + row * D + CA + c0) = rr;
        }
        asm volatile("s_waitcnt lgkmcnt(0)" ::: "memory");
        __syncthreads();
    }
}

__device__ __forceinline__ void p8_shortconv(Frame& F, const Args& a) {
    const bf16* bg = (const bf16*)(a.ws + WS_R2); const bf16* cv = (const bf16*)(a.ws + WS_R2 + 64 * MiB); bf16* y = (bf16*)(a.ws + WS_R2 + 128 * MiB);
    const float* w = a.in[11];
    const int c0 = 8 * (F.tid & 127), rsub = F.tid >> 7;
    f32x2 wk[3][4];
#pragma unroll
    for (int k = 0; k < 3; ++k)
#pragma unroll
        for (int q = 0; q < 4; ++q) wk[k][q] = *(const f32x2*)(w + k * D + c0 + 2 * q);
    constexpr int NU = M / 32; const int upw = (NU + F.G - 1) / F.G;
    for (int i = 0; i < upw; ++i) {
        const int u = F.vcu * upw + i; if (u >= NU) break;
        const int r0 = u * 32 + rsub * 8, t = r0 & (SEQ - 1);
        v4u xc[10], xb8[8];
#pragma unroll
        for (int j = 0; j < 10; ++j) xc[j] = (t + j - 2 >= 0) ? *(const v4u*)(cv + (size_t)(r0 + j - 2) * D + c0) : (v4u){0u, 0u, 0u, 0u};
#pragma unroll
        for (int j = 0; j < 8; ++j) xb8[j] = *(const v4u*)(bg + (size_t)(r0 + j) * D + c0);
#pragma unroll
        for (int j = 0; j < 8; ++j) {
            f32x2 acc[4] = {{0.f, 0.f}, {0.f, 0.f}, {0.f, 0.f}, {0.f, 0.f}};
#pragma unroll
            for (int k = 0; k < 3; ++k) { const v4u x = xc[j + k];
                acc[0] += wk[k][0] * (f32x2){bflo(x.x), bfhi(x.x)}; acc[1] += wk[k][1] * (f32x2){bflo(x.y), bfhi(x.y)}; acc[2] += wk[k][2] * (f32x2){bflo(x.z), bfhi(x.z)}; acc[3] += wk[k][3] * (f32x2){bflo(x.w), bfhi(x.w)}; }
            const v4u b = xb8[j];
            v4u o; o.x = pk2(acc[0][0] * bflo(b.x), acc[0][1] * bfhi(b.x)); o.y = pk2(acc[1][0] * bflo(b.y), acc[1][1] * bfhi(b.y)); o.z = pk2(acc[2][0] * bflo(b.z), acc[2][1] * bfhi(b.z)); o.w = pk2(acc[3][0] * bflo(b.w), acc[3][1] * bfhi(b.w));
            *(v4u*)(y + (size_t)(r0 + j) * D + c0) = o;
        }
    }
}

__device__ __forceinline__ void p12_final_norm(Frame& F, const Args& a) {
    const float* stats = (const float*)(a.ws + WS_STATS); const bf16* xb = (const bf16*)(a.ws + WS_XB); const float* g = a.in[16]; float* out = a.out;
    const int gw = F.vcu * NWAVES + F.wave, NGW = F.G * NWAVES;
    f32x4 gv[4];
#pragma unroll
    for (int j = 0; j < 4; ++j) gv[j] = *(const f32x4*)(g + 8 * F.lane + 512 * (j >> 1) + 4 * (j & 1));
    for (int row = gw; row < M; row += NGW) {
        float s = stats[(size_t)row * 16 + (F.lane & 15)];
        s += __shfl_xor(s, 1); s += __shfl_xor(s, 2); s += __shfl_xor(s, 4); s += __shfl_xor(s, 8);
        const float rstd = 1.0f / sqrtf(s * (1.0f / D) + RMS_EPS);
#pragma unroll
        for (int j = 0; j < 2; ++j) {
            const v4u w = *(const v4u*)(xb + (size_t)row * D + 8 * F.lane + 512 * j);
            const f32x4 v0 = (f32x4){bflo(w.x), bfhi(w.x), bflo(w.y), bfhi(w.y)}, v1 = (f32x4){bflo(w.z), bfhi(w.z), bflo(w.w), bfhi(w.w)};
            float* o = out + (size_t)row * D + 8 * F.lane + 512 * j;
            *(f32x4*)o = v0 * rstd * gv[2 * j]; *(f32x4*)(o + 4) = v1 * rstd * gv[2 * j + 1];
        }
    }
}

__device__ __forceinline__ void rstab_fill(Frame& F, const pg8::StaticOrder& S, const float* stats) {
    LAS float* tab = (LAS float*)(F.lds + RSTAB_OFF); pg8::Unit u;
    if (F.tid < 256)
        for (int i = 0; S.next(i, u); ++i) {
            const f32x4* p = (const f32x4*)(stats + (size_t)(u.pm * 256 + F.tid) * 16);
            const f32x4 a = p[0], b = p[1], c = p[2], d = p[3];
            const float s = ((a[0] + a[1]) + (a[2] + a[3])) + ((b[0] + b[1]) + (b[2] + b[3])) + ((c[0] + c[1]) + (c[2] + c[3])) + ((d[0] + d[1]) + (d[2] + d[3]));
            tab[i * 256 + F.tid] = __builtin_amdgcn_rsqf(s * (1.0f / D) + RMS_EPS) * pg8::KSC;
        }
    __syncthreads();
}
#ifndef STAG_TICKS
#define STAG_TICKS 0
#endif
__device__ __forceinline__ void stagger(int ticks) {
    if (ticks > 0 && ((blockIdx.x >> 3) & 1)) { const unsigned long long t0 = __builtin_amdgcn_s_memrealtime(); while (__builtin_amdgcn_s_memrealtime() - t0 < (unsigned long long)ticks) __builtin_amdgcn_s_sleep(32); }
}
__global__ void __launch_bounds__(NWAVES * 64, 2) hybrid_fwd(Args args) {
    extern __shared__ __attribute__((aligned(16))) unsigned char lds[];
    Frame F;
    F.lds = (LAS unsigned char*)lds;
    F.MISC = (volatile LAS unsigned*)(F.lds + MISC_OFF);
    F.tid = threadIdx.x; F.lane = F.tid & 63; F.wave = __builtin_amdgcn_readfirstlane(F.tid >> 6);
    F.G = gridDim.x; { const int bx = blockIdx.x; F.vcu = (F.G % 8 == 0) ? (bx % 8) * (F.G / 8) + bx / 8 : bx; }
    unsigned char* ws = args.ws;
    F.ctl = (gu32*)(ws + WS_CTL);
    for (int u = F.tid; u < (LDS_BYTES - LDSCTL_OFF) / 4; u += NWAVES * 64) ((LAS unsigned*)(F.lds + LDSCTL_OFF))[u] = 0u;
    __syncthreads();
    XcdBarrier bar; bar.bar = (unsigned*)(F.ctl + CW_BAR); bar.x = 0; bar.st = nullptr;
    if (N_LAUNCHES == 1) bar = xcd_barrier_post((unsigned*)(F.ctl + CW_BAR), F.MISC + 8);
#ifndef PROBE_BAR2
#define PROBE_BAR2 0
#endif
#define GRID_BAR() do { if (N_LAUNCHES == 1) { xcd_barrier(bar); if (PROBE_BAR2) xcd_barrier(bar); } } while (0)
    const int lo = args.ph_lo, hi = args.ph_hi;
#define IN(k) (lo <= (k) && (k) < hi)
#define BOTH(k) (IN(k) && IN((k) + 1))
    bf16* const xb = (bf16*)(ws + WS_XB); float* const stats = (float*)(ws + WS_STATS);
    bf16* const r2 = (bf16*)(ws + WS_R2);

    if (IN(0)) { REPS(0) { p0_prologue(F, args); } if (BOTH(0)) GRID_BAR(); }
    if (IN(1)) {
        stagger(STAG_TICKS);
        REPS(1) {
        pg8::Gemm g{xb, (const bf16*)(ws + WS_W_IN0), M, N_IN0, D}; pg8::StaticOrder S; S.init(M, N_IN0, F.G, (int)blockIdx.x);
        rstab_fill(F, S, stats);
        pg8::EpiIn0 E{(bf16*)((unsigned char*)args.out + OUT_HGLU), r2, (const LAS float*)(F.lds + RSTAB_OFF), QSCALE, F.lds + ESTG_OFF};
        pg8::gemm_phase<pg8::EpiIn0, pg8::StaticOrder, PG8_ALIGN, PG8_SP2>(F.lds + RING_OFF, g, S, E);
        }
        if (BOTH(1)) GRID_BAR();
    }
    if (IN(2)) { REPS(2) { p2_attention(F, args); } if (BOTH(2)) GRID_BAR(); }
    if (IN(3)) { REPS(3) { p3_conv_cat(F, args); } if (BOTH(3)) GRID_BAR(); }
    if (IN(4)) {
        REPS(4) {
        pg8::Gemm g{r2, (const bf16*)(ws + WS_W_OUT0), M, D, D}; pg8::StaticOrder S; S.init(M, D, F.G, (int)blockIdx.x);
        pg8::EpiRes E{xb, stats, F.lds + ESTG_OFF};
        pg8::gemm_phase<pg8::EpiRes, pg8::StaticOrder, PG8_ALIGN, PG8_SP2>(F.lds + RING_OFF, g, S, E);
        }
        if (BOTH(4)) GRID_BAR();
    }
    if (IN(5)) {
        stagger(STAG_TICKS);
        REPS(5) {
        pg8::Gemm g{xb, (const bf16*)(ws + WS_W_UP0), M, FF, D}; pg8::StaticOrder S; S.init(M, FF, F.G, (int)blockIdx.x);
        rstab_fill(F, S, stats);
        pg8::EpiUp E{r2, (const LAS float*)(F.lds + RSTAB_OFF), F.lds + ESTG_OFF};
        pg8::gemm_phase<pg8::EpiUp, pg8::StaticOrder, PG8_ALIGN, PG8_SP2>(F.lds + RING_OFF, g, S, E);
        }
        if (BOTH(5)) GRID_BAR();
    }
    if (IN(6)) {
        REPS(6) {
        pg8::Gemm g{r2, (const bf16*)(ws + WS_W_DN0), M, D, FF}; pg8::StaticOrder S; S.init(M, D, F.G, (int)blockIdx.x);
        pg8::EpiRes E{xb, stats, F.lds + ESTG_OFF};
        pg8::gemm_phase<pg8::EpiRes, pg8::StaticOrder, PG8_ALIGN, PG8_SP2>(F.lds + RING_OFF, g, S, E);
        }
        if (BOTH(6)) GRID_BAR();
    }
    if (IN(7)) {
        stagger(STAG_TICKS);
        REPS(7) {
        pg8::Gemm g{xb, (const bf16*)(ws + WS_W_IN1), M, N_IN1, D}; pg8::StaticOrder S; S.init(M, N_IN1, F.G, (int)blockIdx.x);
        rstab_fill(F, S, stats);
        pg8::EpiIn1 E{(bf16*)(ws + WS_R2 + 64 * MiB), r2, (const LAS float*)(F.lds + RSTAB_OFF), F.lds + ESTG_OFF};
        pg8::gemm_phase<pg8::EpiIn1, pg8::StaticOrder, PG8_ALIGN, PG8_SP2>(F.lds + RING_OFF, g, S, E);
        }
        if (BOTH(7)) GRID_BAR();
    }
    if (IN(8)) { REPS(8) { p8_shortconv(F, args); } if (BOTH(8)) GRID_BAR(); }
    if (IN(9)) {
        REPS(9) {
        pg8::Gemm g{(const bf16*)(ws + WS_R2 + 128 * MiB), (const bf16*)(ws + WS_W_OUT1), M, D, D}; pg8::StaticOrder S; S.init(M, D, F.G, (int)blockIdx.x);
        pg8::EpiRes E{xb, stats, F.lds + ESTG_OFF};
        pg8::gemm_phase<pg8::EpiRes, pg8::StaticOrder, PG8_ALIGN, PG8_SP2>(F.lds + RING_OFF, g, S, E);
        }
        if (BOTH(9)) GRID_BAR();
    }
    if (IN(10)) {
        stagger(STAG_TICKS);
        REPS(10) {
        pg8::Gemm g{xb, (const bf16*)(ws + WS_W_UP1), M, FF, D}; pg8::StaticOrder S; S.init(M, FF, F.G, (int)blockIdx.x);
        rstab_fill(F, S, stats);
        pg8::EpiUp E{r2, (const LAS float*)(F.lds + RSTAB_OFF), F.lds + ESTG_OFF};
        pg8::gemm_phase<pg8::EpiUp, pg8::StaticOrder, PG8_ALIGN, PG8_SP2>(F.lds + RING_OFF, g, S, E);
        }
        if (BOTH(10)) GRID_BAR();
    }
    if (IN(11)) {
        REPS(11) {
        pg8::Gemm g{r2, (const bf16*)(ws + WS_W_DN1), M, D, FF}; pg8::StaticOrder S; S.init(M, D, F.G, (int)blockIdx.x);
#if FUSE_FINAL
        pg8::EpiFinal E{xb, args.out, args.in[16], stats, (unsigned*)(F.ctl + CW_SEAM), (unsigned*)(F.ctl + CW_TMO), F.lds + RING_BYTES};
        pg8::gemm_phase<pg8::EpiFinal, pg8::StaticOrder, true, PG8_SP2>(F.lds + RING_OFF, g, S, E);
#else
        pg8::EpiRes E{xb, stats, F.lds + ESTG_OFF};
        pg8::gemm_phase<pg8::EpiRes, pg8::StaticOrder, PG8_ALIGN, PG8_SP2>(F.lds + RING_OFF, g, S, E);
#endif
        }
        if (BOTH(11)) GRID_BAR();
    }
#if !FUSE_FINAL
    if (IN(12)) { p12_final_norm(F, args); }
#endif
#undef IN
#undef BOTH
}

extern "C" void kernel_launch(void* const* d_in, const int* in_sizes, int n_in, void* d_out, int out_size, void* d_ws, size_t ws_size, hipStream_t stream) {
    static int grid = 0;
    if (grid == 0) {
        if (n_in != 17 || in_sizes[0] != M * D || out_size != M * D || ws_size < WS_END) { fprintf(stderr, "kernel_launch: shape/workspace mismatch (n_in %d in0 %d out %d ws %zu, need %zu)\n", n_in, n_in > 0 ? in_sizes[0] : -1, out_size, ws_size, (size_t)WS_END); grid = -1; return; }
        int dev = 0, cus = 0, per_cu = 0;
        if (hipGetDevice(&dev) != hipSuccess || hipDeviceGetAttribute(&cus, hipDeviceAttributeMultiprocessorCount, dev) != hipSuccess) { grid = -1; return; }
        if (hipFuncSetAttribute((const void*)hybrid_fwd, hipFuncAttributeMaxDynamicSharedMemorySize, LDS_BYTES) != hipSuccess) { fprintf(stderr, "kernel_launch: hipFuncSetAttribute failed\n"); grid = -1; return; }
        if (hipOccupancyMaxActiveBlocksPerMultiprocessor(&per_cu, (const void*)hybrid_fwd, NWAVES * 64, LDS_BYTES) != hipSuccess || per_cu < 1) { fprintf(stderr, "kernel_launch: occupancy query says %d workgroups per CU\n", per_cu); }
        (void)hipGetLastError();
        grid = cus;
    }
    if (grid < 0) return;
    if (hipMemsetAsync((char*)d_ws + WS_CTL, 0, CTL_ZERO_BYTES, stream) != hipSuccess) return;
    Args a{};
    for (int i = 0; i < 17; ++i) a.in[i] = (const float*)d_in[i];
    a.out = (float*)d_out; a.ws = (unsigned char*)d_ws;
    for (int li = 0; li < N_LAUNCHES; ++li) {
        a.ph_lo = (N_LAUNCHES == 1) ? 0 : li; a.ph_hi = (N_LAUNCHES == 1) ? N_PHASES : li + 1; a.li = li;
        hipLaunchKernelGGL(hybrid_fwd, dim3(grid), dim3(NWAVES * 64), LDS_BYTES, stream, a);
    }
}
```
